# Optimizing an MI355X kernel written in HIP

```python
import math
import jax, jax.numpy as jnp
from jax import lax
import numpy as np

D_MODEL = 2048
BATCH = 4
SEQ = 2048
DEPTH = 1
DEC_BATCH = 128
DEC_SEQ = 8
PAST_LEN = 16384
PAGE_SIZE = 128

N_MEM = 256
X_HEADS = 4
X_HEAD_DIM = D_MODEL // 16
D_XATT = X_HEADS * X_HEAD_DIM
D_CONV_A = D_MODEL
CONV_A_W = 3
EXPAND = 2
D_INNER = EXPAND * D_MODEL
SSM_HEAD_DIM = 64
SSM_HEADS = D_INNER // SSM_HEAD_DIM
SSM_GROUPS = 8
D_STATE = 128
CONV_B_W = 4
SSD_CHUNK = 128
D_XBC = D_INNER + 2 * SSM_GROUPS * D_STATE
D_FF = 4 * D_MODEL
EPS = 1e-6
SPLIT_SIZES = (D_CONV_A, D_CONV_A, D_CONV_A, D_INNER, D_XBC, SSM_HEADS, D_XATT, 3 * D_MODEL)
D_IN_PROJ = sum(SPLIT_SIZES)

kernel_name = "hybrid_conv_ssd_memxattn_step"


def _split_points(sizes):
    return [int(v) for v in np.cumsum(np.array(sizes))[:-1]]


def rmsnorm(x, g):
    xf = x.astype(jnp.float32)
    y = xf * lax.rsqrt(jnp.mean(xf * xf, axis=-1, keepdims=True) + EPS)
    return (y * g.astype(jnp.float32)).astype(x.dtype)


def gated_group_rmsnorm(y, z, g):
    b, l, d = y.shape
    u = (y.astype(jnp.float32) * jax.nn.silu(z.astype(jnp.float32))).reshape(b, l, SSM_GROUPS, d // SSM_GROUPS)
    u = u * lax.rsqrt(jnp.mean(u * u, axis=-1, keepdims=True) + EPS)
    return (u.reshape(b, l, d) * g.astype(jnp.float32)).astype(y.dtype)


def causal_dwconv(x, prev, w):
    K = w.shape[0]
    L = x.shape[1]
    u = jnp.concatenate([prev.astype(x.dtype), x], axis=1)
    y = u[:, 0:L] * w[0]
    for k in range(1, K):
        y = y + u[:, k:k + L] * w[k]
    return y, u[:, -(K - 1):]


def ssd(x, dt, A, B, C, h0):
    b, l, nh, p = x.shape
    n = B.shape[-1]
    q = math.gcd(l, SSD_CHUNK)
    c = l // q
    r = nh // SSM_GROUPS
    xr = x.reshape(b, c, q, SSM_GROUPS, r, p)
    dtr = dt.reshape(b, c, q, SSM_GROUPS, r)
    Br = B.reshape(b, c, q, SSM_GROUPS, n)
    Cr = C.reshape(b, c, q, SSM_GROUPS, n)
    acum = jnp.cumsum(dtr * A.reshape(SSM_GROUPS, r), axis=2)
    xdt = xr * dtr[..., None]
    mask = jnp.tril(jnp.ones((q, q), dtype=bool))[None, None, :, :, None, None]
    seg = acum[:, :, :, None] - acum[:, :, None, :]
    decay = jnp.exp(jnp.where(mask, seg, -jnp.inf))
    cb = jnp.einsum('bcqgn,bcsgn->bcqsg', Cr, Br)
    y_diag = jnp.einsum('bcqsgr,bcsgrp->bcqgrp', cb[..., None] * decay, xdt)
    decay_end = jnp.exp(acum[:, :, -1:] - acum)
    states = jnp.einsum('bcsgn,bcsgrp->bcgrpn', Br, xdt * decay_end[..., None])
    chunk_decay = jnp.exp(acum[:, :, -1])

    def step(h, inp):
        s, d = inp
        return h * d[..., None, None] + s, h

    h_final, h_prev = lax.scan(step, h0.reshape(b, SSM_GROUPS, r, p, n),
                               (jnp.moveaxis(states, 1, 0), jnp.moveaxis(chunk_decay, 1, 0)))
    h_prev = jnp.moveaxis(h_prev, 0, 1)
    y_off = jnp.einsum('bcqgn,bcgrpn->bcqgrp', Cr, h_prev) * jnp.exp(acum)[..., None]
    y = (y_diag + y_off).reshape(b, l, nh, p)
    return y, h_final.reshape(b, nh, p, n)


def mem_kv(mem, g, w_kv):
    b, m, _ = mem.shape
    kv = rmsnorm(mem, g) @ w_kv
    k, v = jnp.split(kv, 2, axis=-1)
    return k.reshape(b, m, X_HEADS, X_HEAD_DIM), v.reshape(b, m, X_HEADS, X_HEAD_DIM)


def cross_attn(q, k, v):
    s = jnp.einsum('blhd,bmhd->bhlm', q, k).astype(jnp.float32) * (X_HEAD_DIM ** -0.5)
    pr = jax.nn.softmax(s, axis=-1)
    return jnp.einsum('bhlm,bmhd->blhd', pr.astype(v.dtype), v)


def _layer(x, conv_a_prev, conv_b_prev, ssm_prev, mem_k, mem_v, p):
    b, l, _ = x.shape
    xn = rmsnorm(x, p['norm_mix_pre'])
    proj = xn @ p['w_in']
    b_a, c_a, h_a, z, xbc, dt_raw, q, gates = jnp.split(proj, _split_points(SPLIT_SIZES), axis=-1)
    conv_a_out, conv_a_new = causal_dwconv(c_a * h_a, conv_a_prev, p['conv_a_w'])
    y_a = (b_a * conv_a_out) @ p['w_out_a']
    xbc_c, conv_b_new = causal_dwconv(xbc, conv_b_prev, p['conv_b_w'])
    xbc_c = jax.nn.silu(xbc_c + p['conv_b_bias'])
    xs, Bs, Cs = jnp.split(xbc_c, [D_INNER, D_INNER + SSM_GROUPS * D_STATE], axis=-1)
    xs_h = xs.reshape(b, l, SSM_HEADS, SSM_HEAD_DIM).astype(jnp.float32)
    dt = jax.nn.softplus(dt_raw.astype(jnp.float32) + p['dt_bias'].astype(jnp.float32))
    A = -jnp.exp(p['a_log'].astype(jnp.float32))
    y_s, ssm_new = ssd(xs_h, dt, A,
                       Bs.reshape(b, l, SSM_GROUPS, D_STATE).astype(jnp.float32),
                       Cs.reshape(b, l, SSM_GROUPS, D_STATE).astype(jnp.float32),
                       ssm_prev.astype(jnp.float32))
    y_s = y_s + p['d_skip'].astype(jnp.float32)[:, None] * xs_h
    y_s = y_s.reshape(b, l, D_INNER).astype(x.dtype)
    y_b = gated_group_rmsnorm(y_s, z, p['ssm_norm_w']) @ p['w_out_b']
    o = cross_attn(q.reshape(b, l, X_HEADS, X_HEAD_DIM), mem_k, mem_v).reshape(b, l, D_XATT)
    y_x = o @ p['w_out_x']
    g_a, g_b, g_x = jnp.split(jax.nn.sigmoid(gates), 3, axis=-1)
    mixed = (g_a * y_a + g_b * y_b + g_x * y_x) @ p['w_o']
    x = x + rmsnorm(mixed, p['norm_mix_post'])
    hn = rmsnorm(x, p['norm_mlp_pre'])
    ff = jnp.square(jax.nn.relu(hn @ p['w_ff1'])) @ p['w_ff2']
    x = x + rmsnorm(ff, p['norm_mlp_post'])
    return x, conv_a_new, conv_b_new, ssm_new.astype(ssm_prev.dtype)


def setup_inputs(seed: int = 0) -> dict:
    key = jax.random.key(seed)
    ks = jax.random.split(key, 40)

    def nrm(k, shape, scale):
        return jax.random.normal(k, shape, jnp.float32) * scale

    def gain(k, shape):
        return 1.0 + nrm(k, shape, 0.02)

    dt0 = jnp.exp(jax.random.uniform(ks[30], (DEPTH, SSM_HEADS), jnp.float32, math.log(1e-3), math.log(1e-1)))
    dt_bias = dt0 + jnp.log(-jnp.expm1(-dt0))
    a_log = jnp.log(jax.random.uniform(ks[31], (DEPTH, SSM_HEADS), jnp.float32, 1.0, 16.0))
    return {
        "x_prompt": nrm(ks[0], (BATCH, SEQ, D_MODEL), 1.0),
        "x_sample": nrm(ks[1], (DEC_BATCH, DEC_SEQ, D_MODEL), 1.0),
        "mem_prompt": nrm(ks[2], (BATCH, N_MEM, D_MODEL), 1.0),
        "cache_mem_k": nrm(ks[3], (DEPTH, DEC_BATCH, N_MEM, X_HEADS, X_HEAD_DIM), 1.0),
        "cache_mem_v": nrm(ks[4], (DEPTH, DEC_BATCH, N_MEM, X_HEADS, X_HEAD_DIM), 1.0),
        "state_conv_a": nrm(ks[5], (DEPTH, DEC_BATCH, CONV_A_W - 1, D_CONV_A), 1.0),
        "state_conv_b": nrm(ks[6], (DEPTH, DEC_BATCH, CONV_B_W - 1, D_XBC), 1.0),
        "state_ssm": nrm(ks[7], (DEPTH, DEC_BATCH, SSM_HEADS, SSM_HEAD_DIM, D_STATE), 0.1),
        "norm_mix_pre": gain(ks[8], (DEPTH, D_MODEL)),
        "norm_mix_post": gain(ks[9], (DEPTH, D_MODEL)),
        "norm_mlp_pre": gain(ks[10], (DEPTH, D_MODEL)),
        "norm_mlp_post": gain(ks[11], (DEPTH, D_MODEL)),
        "norm_mem": gain(ks[12], (DEPTH, D_MODEL)),
        "w_in": nrm(ks[13], (DEPTH, D_MODEL, D_IN_PROJ), D_MODEL ** -0.5),
        "conv_a_w": nrm(ks[14], (DEPTH, CONV_A_W, D_CONV_A), CONV_A_W ** -0.5),
        "w_out_a": nrm(ks[15], (DEPTH, D_CONV_A, D_MODEL), D_CONV_A ** -0.5),
        "conv_b_w": nrm(ks[16], (DEPTH, CONV_B_W, D_XBC), CONV_B_W ** -0.5),
        "conv_b_bias": nrm(ks[17], (DEPTH, D_XBC), 0.02),
        "dt_bias": dt_bias,
        "a_log": a_log,
        "d_skip": 1.0 + nrm(ks[18], (DEPTH, SSM_HEADS), 0.1),
        "ssm_norm_w": gain(ks[19], (DEPTH, D_INNER)),
        "w_out_b": nrm(ks[20], (DEPTH, D_INNER, D_MODEL), D_INNER ** -0.5),
        "w_mem_kv": nrm(ks[21], (DEPTH, D_MODEL, 2 * D_XATT), D_MODEL ** -0.5),
        "w_out_x": nrm(ks[22], (DEPTH, D_XATT, D_MODEL), D_XATT ** -0.5),
        "w_o": nrm(ks[23], (DEPTH, D_MODEL, D_MODEL), D_MODEL ** -0.5),
        "w_ff1": nrm(ks[24], (DEPTH, D_MODEL, D_FF), D_MODEL ** -0.5),
        "w_ff2": nrm(ks[25], (DEPTH, D_FF, D_MODEL), D_FF ** -0.5),
    }


def reference(x_prompt, x_sample, mem_prompt, cache_mem_k, cache_mem_v, state_conv_a, state_conv_b,
              state_ssm, norm_mix_pre, norm_mix_post, norm_mlp_pre, norm_mlp_post, norm_mem, w_in,
              conv_a_w, w_out_a, conv_b_w, conv_b_bias, dt_bias, a_log, d_skip, ssm_norm_w, w_out_b,
              w_mem_kv, w_out_x, w_o, w_ff1, w_ff2):
    bp = x_prompt.shape[0]
    yp, ys = x_prompt, x_sample
    mk_p, mv_p, ca_p, cb_p, ss_p, ca_s, cb_s, ss_s = [], [], [], [], [], [], [], []
    for l in range(DEPTH):
        p = dict(norm_mix_pre=norm_mix_pre[l], norm_mix_post=norm_mix_post[l],
                 norm_mlp_pre=norm_mlp_pre[l], norm_mlp_post=norm_mlp_post[l], w_in=w_in[l],
                 conv_a_w=conv_a_w[l], w_out_a=w_out_a[l], conv_b_w=conv_b_w[l],
                 conv_b_bias=conv_b_bias[l], dt_bias=dt_bias[l], a_log=a_log[l], d_skip=d_skip[l],
                 ssm_norm_w=ssm_norm_w[l], w_out_b=w_out_b[l], w_out_x=w_out_x[l], w_o=w_o[l],
                 w_ff1=w_ff1[l], w_ff2=w_ff2[l])
        mkp, mvp = mem_kv(mem_prompt, norm_mem[l], w_mem_kv[l])
        yp, cap, cbp, ssp = _layer(
            yp,
            jnp.zeros((bp, CONV_A_W - 1, D_CONV_A), yp.dtype),
            jnp.zeros((bp, CONV_B_W - 1, D_XBC), yp.dtype),
            jnp.zeros((bp, SSM_HEADS, SSM_HEAD_DIM, D_STATE), state_ssm.dtype),
            mkp, mvp, p)
        ys, cas, cbs, sss = _layer(ys, state_conv_a[l], state_conv_b[l], state_ssm[l],
                                   cache_mem_k[l], cache_mem_v[l], p)
        mk_p.append(mkp); mv_p.append(mvp); ca_p.append(cap); cb_p.append(cbp); ss_p.append(ssp)
        ca_s.append(cas); cb_s.append(cbs); ss_s.append(sss)
    return (yp, ys, jnp.stack(mk_p), jnp.stack(mv_p), jnp.stack(ca_p), jnp.stack(cb_p), jnp.stack(ss_p),
            jnp.stack(ca_s), jnp.stack(cb_s), jnp.stack(ss_s))
```

```cpp
#include <hip/hip_runtime.h>
#include <cstdio>
#include <cstdint>

constexpr int DM = 2048, NTOK_P = 8192, NTOK_S = 1024, NTOK = 9216, NMEMROW = 1024;
constexpr int SEQ_P = 2048, SEQ_S = 8, NB_P = 4, NB_S = 128;
constexpr int D_INNER = 4096, D_XBC = 6144, NHEAD = 64, HDIM = 64, NGRP = 8, DSTATE = 128, DFF = 8192, D_XATT = 512;
constexpr int C_BA = 0, C_CA = 2048, C_HA = 4096, C_Z = 6144, C_XBC = 10240, C_Q = 16384, C_G = 16896, C_DT = 23040;
constexpr int NPROJ = 23040, NPAD = 23296;
constexpr float EPS = 1e-6f;
constexpr size_t O_Y = 0, O_MK = 18874368, O_MV = 19398656, O_CAP = 19922944, O_CBP = 19939328, O_SSP = 20013056, O_CAS = 22110208, O_CBS = 22634496, O_SSS = 24993792;
namespace pg8 {
#define PG8_LAS __attribute__((address_space(3)))
typedef unsigned short bf16_t;
typedef short bf16x8 __attribute__((ext_vector_type(8)));
typedef float f32x4 __attribute__((ext_vector_type(4)));
typedef unsigned u32x4 __attribute__((ext_vector_type(4)));
constexpr int BM = 256, BK = 64, HALF = 128, HTB = HALF * BK * 2  , STAGE_BYTES = 8 * HTB, NXCD = 8, WGM = 8;

__host__ __device__ __forceinline__ int lds_byte(int r, int c) { const int st = (r >> 4) * 2 + (c >> 5), rr = r & 15, cc = c & 31, ob = rr * 64 + cc * 2; return st * 1024 + (ob ^ (((ob >> 9) & 1) << 5)); }
__host__ __device__ __forceinline__ void stage_rc(int b, int& R, int& C) { const int st = b / 1024, sb = b % 1024, swz = sb ^ (((sb >> 9) & 1) << 5); R = (st >> 1) * 16 + swz / 64; C = (st & 1) * 32 + (swz % 64) / 2; }
__host__ __device__ __forceinline__ int perm32(int rho) { const int n = rho >> 4, i = rho & 15; return 8 * (i >> 2) + 4 * n + (i & 3); }

struct Unit { int pm, pn; };
struct Gemm { const bf16_t* A; const bf16_t* Bt; int M, N, K; };

struct StaticOrder {
    int nM, nN, nwg, G, c;
    __host__ __device__ void init(int M, int N, int G_, int c_) { nM = M / BM; nN = N / BM; nwg = nM * nN; G = G_; c = c_; }
    __host__ __device__ bool next(int i, Unit& u) const {
        const long L = (long)i * G + c; if (L >= nwg) return false;
        int wgid = (int)L; { const int q = nwg / NXCD, r = nwg % NXCD, xcd = wgid % NXCD, off = wgid / NXCD; wgid = (xcd < r ? xcd * (q + 1) : r * (q + 1) + (xcd - r) * q) + off; }
        const int nig = WGM * nN, gid = wgid / nig, fm = gid * WGM, gsz = (nM - fm) < WGM ? (nM - fm) : WGM;
        u.pm = fm + ((wgid % nig) % gsz); u.pn = (wgid % nig) / gsz; return true;
    }
    __device__ __forceinline__ void a_ready(const Unit&) const {}
    __device__ __forceinline__ void done(const Unit&) const {}
};


__device__ __forceinline__ unsigned cvt_pk_bf16(float lo, float hi) { unsigned r; asm volatile("v_cvt_pk_bf16_f32 %0, %1, %2" : "=v"(r) : "v"(lo), "v"(hi)); return r; }
__device__ __forceinline__ float bf_lo(unsigned w) { return __uint_as_float(w << 16); }
__device__ __forceinline__ float bf_hi(unsigned w) { return __uint_as_float(w & 0xffff0000u); }
__device__ __forceinline__ float sigmoidf_(float x) { return __builtin_amdgcn_rcpf(1.0f + __expf(-x)); }
typedef unsigned u32x2 __attribute__((ext_vector_type(2)));

struct EpiProj {
    static constexpr bool PERM = true, AFTER_DRAIN = false;
    bf16_t* P; float* DT; const float* dt_bias;
    __device__ __forceinline__ void operator()(const f32x4 (&acc)[2][2][4][2], const Unit& u, int wr, int wc, int fr, int fq) const {
        const int row0 = u.pm * BM + wr * 64 + fr, colt = u.pn * BM;
        if (colt < C_DT) {
            const bool gate = colt >= C_G;
            const int col0 = colt + wc * 32 + 8 * fq;
#pragma unroll
            for (int ai = 0; ai < 2; ++ai)
#pragma unroll
                for (int m = 0; m < 4; ++m) { bf16_t* rowp = P + (size_t)(row0 + ai * HALF + m * 16) * NPROJ + col0;
#pragma unroll
                    for (int bj = 0; bj < 2; ++bj) { f32x4 v0 = acc[ai][bj][m][0], v1 = acc[ai][bj][m][1];
                        if (gate) {
#pragma unroll
                            for (int i = 0; i < 4; ++i) { v0[i] = sigmoidf_(v0[i]); v1[i] = sigmoidf_(v1[i]); } }
                        u32x4 w; w.x = cvt_pk_bf16(v0[0], v0[1]); w.y = cvt_pk_bf16(v0[2], v0[3]); w.z = cvt_pk_bf16(v1[0], v1[1]); w.w = cvt_pk_bf16(v1[2], v1[3]);
                        *(u32x4*)(rowp + bj * HALF) = w; } }
        } else if (wc < 2) {
            const int c0 = wc * 32 + 8 * fq;
#pragma unroll
            for (int ai = 0; ai < 2; ++ai)
#pragma unroll
                for (int m = 0; m < 4; ++m) { float* rowp = DT + (size_t)(row0 + ai * HALF + m * 16) * 64 + c0;
#pragma unroll
                    for (int n = 0; n < 2; ++n) { f32x4 v = acc[ai][0][m][n]; const f32x4 bv = *(const f32x4*)(dt_bias + c0 + 4 * n);
#pragma unroll
                        for (int i = 0; i < 4; ++i) { const float x = v[i] + bv[i]; v[i] = x > 20.f ? x : log1pf(__expf(x)); }
                        *(f32x4*)(rowp + 4 * n) = v; } }
        }
    }
};
struct EpiRelu2 {
    static constexpr bool PERM = true, AFTER_DRAIN = false;
    bf16_t* O; int ldc;
    __device__ __forceinline__ void operator()(const f32x4 (&acc)[2][2][4][2], const Unit& u, int wr, int wc, int fr, int fq) const {
        const int row0 = u.pm * BM + wr * 64 + fr, col0 = u.pn * BM + wc * 32 + 8 * fq;
#pragma unroll
        for (int ai = 0; ai < 2; ++ai)
#pragma unroll
            for (int m = 0; m < 4; ++m) { bf16_t* rowp = O + (size_t)(row0 + ai * HALF + m * 16) * ldc + col0;
#pragma unroll
                for (int bj = 0; bj < 2; ++bj) { f32x4 v0 = acc[ai][bj][m][0], v1 = acc[ai][bj][m][1];
#pragma unroll
                    for (int i = 0; i < 4; ++i) { const float a = fmaxf(v0[i], 0.f), b = fmaxf(v1[i], 0.f); v0[i] = a * a; v1[i] = b * b; }
                    u32x4 w; w.x = cvt_pk_bf16(v0[0], v0[1]); w.y = cvt_pk_bf16(v0[2], v0[3]); w.z = cvt_pk_bf16(v1[0], v1[1]); w.w = cvt_pk_bf16(v1[2], v1[3]);
                    *(u32x4*)(rowp + bj * HALF) = w; } }
    }
};
struct EpiF32 {
    static constexpr bool PERM = false, AFTER_DRAIN = false;
    float* C; int ldc;
    __device__ __forceinline__ void operator()(const f32x4 (&acc)[2][2][4][2], const Unit& u, int wr, int wc, int fr, int fq) const {
        const int row0 = u.pm * BM + wr * 64 + fr, col0 = u.pn * BM + wc * 32 + 4 * fq;
#pragma unroll
        for (int ai = 0; ai < 2; ++ai)
#pragma unroll
            for (int m = 0; m < 4; ++m) { float* rowp = C + (size_t)(row0 + ai * HALF + m * 16) * ldc + col0;
#pragma unroll
                for (int bj = 0; bj < 2; ++bj)
#pragma unroll
                    for (int n = 0; n < 2; ++n) *(f32x4*)(rowp + bj * HALF + n * 16) = acc[ai][bj][m][n]; }
    }
};
struct EpiKV {
    static constexpr bool PERM = false, AFTER_DRAIN = false;
    float* OK; float* OV; bf16_t* KVB;
    __device__ __forceinline__ void operator()(const f32x4 (&acc)[2][2][4][2], const Unit& u, int wr, int wc, int fr, int fq) const {
        const int row0 = u.pm * BM + wr * 64 + fr, col0 = u.pn * BM + wc * 32 + 4 * fq;
#pragma unroll
        for (int ai = 0; ai < 2; ++ai)
#pragma unroll
            for (int m = 0; m < 4; ++m) { const int row = row0 + ai * HALF + m * 16;
#pragma unroll
                for (int bj = 0; bj < 2; ++bj)
#pragma unroll
                    for (int n = 0; n < 2; ++n) { const int col = col0 + bj * HALF + n * 16; const f32x4 v = acc[ai][bj][m][n];
                        float* dst = col < 512 ? OK + (size_t)row * 512 + col : OV + (size_t)row * 512 + (col - 512);
                        *(f32x4*)dst = v;
                        u32x2 w; w.x = cvt_pk_bf16(v[0], v[1]); w.y = cvt_pk_bf16(v[2], v[3]); *(u32x2*)(KVB + (size_t)row * 1024 + col) = w; } }
    }
};
template <int MODE> struct EpiGate {
    static constexpr bool PERM = false, AFTER_DRAIN = false;
    float* T; const bf16_t* P; int gcol0; bf16_t* OUT;
    __device__ __forceinline__ void operator()(const f32x4 (&acc)[2][2][4][2], const Unit& u, int wr, int wc, int fr, int fq) const {
        const int row0 = u.pm * BM + wr * 64 + fr, col0 = u.pn * BM + wc * 32 + 4 * fq;
#pragma unroll
        for (int ai = 0; ai < 2; ++ai)
#pragma unroll
            for (int m = 0; m < 4; ++m) { const int row = row0 + ai * HALF + m * 16;
#pragma unroll
                for (int bj = 0; bj < 2; ++bj)
#pragma unroll
                    for (int n = 0; n < 2; ++n) { const int col = col0 + bj * HALF + n * 16; const f32x4 a = acc[ai][bj][m][n];
                        const u32x2 gw = *(const u32x2*)(P + (size_t)row * NPROJ + gcol0 + col);
                        f32x4 v; v[0] = a[0] * bf_lo(gw.x); v[1] = a[1] * bf_hi(gw.x); v[2] = a[2] * bf_lo(gw.y); v[3] = a[3] * bf_hi(gw.y);
                        float* tp = T + (size_t)row * DM + col;
                        if (MODE == 0) *(f32x4*)tp = v;
                        else if (MODE == 1) *(f32x4*)tp = *(const f32x4*)tp + v;
                        else { const f32x4 o = *(const f32x4*)tp + v; u32x2 w; w.x = cvt_pk_bf16(o[0], o[1]); w.y = cvt_pk_bf16(o[2], o[3]); *(u32x2*)(OUT + (size_t)row * DM + col) = w; } } }
    }
};

template <class Epi, class Sched, bool ALIGN_EPI = false, bool SP2 = false>
__device__ __forceinline__ void gemm_phase(PG8_LAS unsigned char* lds, const Gemm g, const Sched& S, const Epi& E) {
    const int tid = threadIdx.x, wid = __builtin_amdgcn_readfirstlane(tid >> 6), lane = tid & 63, wr = wid >> 2, wc = wid & 3, fr = lane & 15, fq = lane >> 4;
    const int K = g.K, nt = K / BK;
    unsigned voffA[2], voffB[2];
#pragma unroll
    for (int i = 0; i < 2; ++i) { int R, C; stage_rc(tid * 16 + i * 8192, R, C); const int Rb = Epi::PERM ? ((R & ~31) + perm32(R & 31)) : R;
        voffA[i] = (unsigned)(R * K + C) * 2u; voffB[i] = (unsigned)(Rb * K + C) * 2u; }
    const size_t kstep = (size_t)(BK * 2);
    const size_t hstep = (size_t)HALF * K * 2;
    const size_t tstep = 2 * hstep;
    const unsigned ldsw = (unsigned)wid * 1024u;
    const int aoff = lds_byte(wr * 64 + fr, fq * 8), boff = lds_byte(wc * 32 + fr, fq * 8);
#define PG8_SA(b, h) (((b) * 2 + (h)) * HTB)
#define PG8_SB(b, h) ((4 + (b) * 2 + (h)) * HTB)
#define PG8_STAGE(bufoff, gbase, voff) do { _Pragma("unroll") for (int _i = 0; _i < 2; ++_i) \
        __builtin_amdgcn_global_load_lds((const unsigned*)((const char*)(gbase) + (voff)[_i]), (PG8_LAS unsigned*)(lds + (bufoff) + ldsw + _i * 8192), 16, 0, 0); } while (0)
#define PG8_LDA(dst, b, h) do { _Pragma("unroll") for (int m = 0; m < 4; ++m) _Pragma("unroll") for (int k = 0; k < 2; ++k) dst[m][k] = *(const PG8_LAS bf16x8*)(lds + PG8_SA(b, h) + aoff + m * 2048 + k * 1024); } while (0)
#define PG8_LDB(dst, b, h) do { _Pragma("unroll") for (int n = 0; n < 2; ++n) _Pragma("unroll") for (int k = 0; k < 2; ++k) dst[n][k] = *(const PG8_LAS bf16x8*)(lds + PG8_SB(b, h) + boff + n * 2048 + k * 1024); } while (0)
#define PG8_MMA(ai, bj, At, Bt) do { __builtin_amdgcn_s_setprio(1); _Pragma("unroll") for (int m = 0; m < 4; ++m) _Pragma("unroll") for (int n = 0; n < 2; ++n) _Pragma("unroll") for (int k = 0; k < 2; ++k) \
        acc[ai][bj][m][n] = __builtin_amdgcn_mfma_f32_16x16x32_bf16(Bt[n][k], At[m][k], acc[ai][bj][m][n], 0, 0, 0); __builtin_amdgcn_s_setprio(0); } while (0)
#define PG8_WAIT_V(n) asm volatile("s_waitcnt vmcnt(" #n ")" ::: "memory")
#define PG8_WAIT_L(n) asm volatile("s_waitcnt lgkmcnt(" #n ")" ::: "memory")
#define PG8_BAR __builtin_amdgcn_s_barrier()
#define PG8_SCHED __builtin_amdgcn_sched_barrier(0)
    Unit cur, nxt; int ui = 0;
    if (!S.next(0, cur)) return;
    f32x4 acc[2][2][4][2];
#pragma unroll
    for (int a = 0; a < 2; ++a)
#pragma unroll
        for (int b = 0; b < 2; ++b)
#pragma unroll
            for (int m = 0; m < 4; ++m)
#pragma unroll
                for (int n = 0; n < 2; ++n) acc[a][b][m][n] = (f32x4){0.f, 0.f, 0.f, 0.f};
    bf16x8 At[4][2], B0[2][2], B1[2][2];
    const char* cA = (const char*)g.A + (size_t)cur.pm * tstep; const char* cB = (const char*)g.Bt + (size_t)cur.pn * tstep;
    S.a_ready(cur);
    if constexpr (SP2) {
        PG8_STAGE(PG8_SB(0, 0), cB, voffB); PG8_STAGE(PG8_SB(0, 1), cB + hstep, voffB); PG8_STAGE(PG8_SA(0, 0), cA, voffA); PG8_STAGE(PG8_SA(0, 1), cA + hstep, voffA);
        if (wr == 1) PG8_BAR;
        PG8_WAIT_V(2); PG8_BAR;
        PG8_STAGE(PG8_SB(1, 0), cB + kstep, voffB); PG8_STAGE(PG8_SA(1, 0), cA + kstep, voffA); PG8_STAGE(PG8_SB(1, 1), cB + hstep + kstep, voffB);
        PG8_WAIT_V(6); PG8_BAR;
    } else {
        PG8_STAGE(PG8_SB(0, 0), cB, voffB); PG8_STAGE(PG8_SA(0, 0), cA, voffA); PG8_STAGE(PG8_SB(0, 1), cB + hstep, voffB); PG8_STAGE(PG8_SA(0, 1), cA + hstep, voffA);
        if (wr == 1) PG8_BAR;
        PG8_WAIT_V(4); PG8_BAR;
        PG8_STAGE(PG8_SB(1, 0), cB + kstep, voffB); PG8_STAGE(PG8_SA(1, 0), cA + kstep, voffA); PG8_STAGE(PG8_SB(1, 1), cB + hstep + kstep, voffB);
        PG8_WAIT_V(6); PG8_BAR;
    }
    for (;;) {
        const bool has_next = S.next(ui + 1, nxt);
        const char* nA = has_next ? (const char*)g.A + (size_t)nxt.pm * tstep : cA; const char* nB = has_next ? (const char*)g.Bt + (size_t)nxt.pn * tstep : cB;
        for (int t = 0; t < nt; t += 2) {
            const bool last = (t == nt - 2);
            const char* a1 = cA + (size_t)(t + 1) * kstep;
            const char* a2 = last ? nA : cA + (size_t)(t + 2) * kstep; const char* b2 = last ? nB : cB + (size_t)(t + 2) * kstep;
            const char* a3 = a2 + kstep; const char* b3 = b2 + kstep;
            if (last && has_next) S.a_ready(nxt);
            if constexpr (SP2) {
            PG8_LDB(B0, 0, 0); PG8_LDB(B1, 0, 1); PG8_SCHED; PG8_LDA(At, 0, 0); PG8_STAGE(PG8_SA(1, 1), a1 + hstep, voffA);
            PG8_WAIT_V(8); PG8_WAIT_L(0); PG8_BAR; PG8_MMA(0, 0, At, B0); PG8_MMA(0, 1, At, B1); PG8_BAR; PG8_SCHED;
            PG8_LDA(At, 0, 1); PG8_STAGE(PG8_SB(0, 0), b2, voffB); PG8_STAGE(PG8_SB(0, 1), b2 + hstep, voffB); PG8_STAGE(PG8_SA(0, 0), a2, voffA);
            PG8_WAIT_V(8); PG8_WAIT_L(0); PG8_BAR; PG8_MMA(1, 0, At, B0); PG8_MMA(1, 1, At, B1); PG8_BAR; PG8_SCHED;
            PG8_LDB(B0, 1, 0); PG8_LDB(B1, 1, 1); PG8_SCHED; PG8_LDA(At, 1, 0); PG8_STAGE(PG8_SA(0, 1), a2 + hstep, voffA);
            PG8_WAIT_V(8); PG8_WAIT_L(0); PG8_BAR; PG8_MMA(0, 0, At, B0); PG8_MMA(0, 1, At, B1); PG8_BAR; PG8_SCHED;
            PG8_LDA(At, 1, 1); PG8_STAGE(PG8_SB(1, 0), b3, voffB); PG8_STAGE(PG8_SB(1, 1), b3 + hstep, voffB); PG8_STAGE(PG8_SA(1, 0), a3, voffA);
            PG8_WAIT_V(8); PG8_WAIT_L(0); PG8_BAR; PG8_MMA(1, 0, At, B0); PG8_MMA(1, 1, At, B1); PG8_BAR; PG8_SCHED;
            } else {
            PG8_LDB(B0, 0, 0); PG8_SCHED; PG8_LDA(At, 0, 0); PG8_STAGE(PG8_SA(1, 1), a1 + hstep, voffA);
            PG8_WAIT_L(8); PG8_BAR; PG8_WAIT_L(0); PG8_MMA(0, 0, At, B0); PG8_BAR; PG8_SCHED;
            PG8_LDB(B1, 0, 1); PG8_STAGE(PG8_SB(0, 0), b2, voffB);
            PG8_BAR; PG8_WAIT_L(0); PG8_MMA(0, 1, At, B1); PG8_BAR;
            PG8_LDA(At, 0, 1); PG8_STAGE(PG8_SA(0, 0), a2, voffA);
            PG8_BAR; PG8_WAIT_L(0); PG8_MMA(1, 0, At, B0); PG8_BAR; PG8_SCHED;
            PG8_STAGE(PG8_SB(0, 1), b2 + hstep, voffB);
            PG8_WAIT_V(6); PG8_BAR; PG8_MMA(1, 1, At, B1); PG8_BAR;
            PG8_LDB(B0, 1, 0); PG8_SCHED; PG8_LDA(At, 1, 0); PG8_STAGE(PG8_SA(0, 1), a2 + hstep, voffA);
            PG8_WAIT_L(8); PG8_BAR; PG8_WAIT_L(0); PG8_MMA(0, 0, At, B0); PG8_BAR; PG8_SCHED;
            PG8_LDB(B1, 1, 1); PG8_STAGE(PG8_SB(1, 0), b3, voffB);
            PG8_BAR; PG8_WAIT_L(0); PG8_MMA(0, 1, At, B1); PG8_BAR;
            PG8_LDA(At, 1, 1); PG8_STAGE(PG8_SA(1, 0), a3, voffA);
            PG8_BAR; PG8_WAIT_L(0); PG8_MMA(1, 0, At, B0); PG8_BAR; PG8_SCHED;
            PG8_STAGE(PG8_SB(1, 1), b3 + hstep, voffB);
            PG8_WAIT_V(6); PG8_BAR; PG8_MMA(1, 1, At, B1); PG8_BAR;
            }
        }
        if constexpr (ALIGN_EPI) { if (wr == 0) PG8_BAR; }
        if constexpr (!Epi::AFTER_DRAIN) { E(acc, cur, wr, wc, fr, fq); S.done(cur); }
        if (!has_next) break;
#pragma unroll
        for (int a = 0; a < 2; ++a)
#pragma unroll
            for (int b = 0; b < 2; ++b)
#pragma unroll
                for (int m = 0; m < 4; ++m)
#pragma unroll
                    for (int n = 0; n < 2; ++n) acc[a][b][m][n] = (f32x4){0.f, 0.f, 0.f, 0.f};
        cur = nxt; cA = nA; cB = nB; ++ui;
        if constexpr (ALIGN_EPI) { if (wr == 1) PG8_BAR; }
    }
    PG8_WAIT_V(0);
    if constexpr (!ALIGN_EPI) { if (wr == 0) PG8_BAR; }
    PG8_BAR;
    if constexpr (Epi::AFTER_DRAIN) { E.fused(acc, cur, wr, wc, fr, fq, lds, wid, lane); S.done(cur); }
#undef PG8_SA
#undef PG8_SB
#undef PG8_STAGE
#undef PG8_LDA
#undef PG8_LDB
#undef PG8_MMA
#undef PG8_WAIT_V
#undef PG8_WAIT_L
#undef PG8_BAR
#undef PG8_SCHED
}
}

constexpr int NWAVES = 8;
#ifndef MK_PER_PHASE
#define MK_PER_PHASE 1
#endif
constexpr int N_PHASES = 11;

constexpr size_t MiB = 1u << 20;
constexpr size_t WS_CTL = 0, CTL_ZERO_BYTES = 1 * MiB;
constexpr size_t WS_WIN = 2 * MiB;
constexpr size_t WS_WA = 94 * MiB, WS_WB = 102 * MiB, WS_WX = 118 * MiB, WS_WO = 120 * MiB, WS_W1 = 128 * MiB, WS_W2 = 160 * MiB, WS_WKV = 192 * MiB;
constexpr size_t WS_XN = 196 * MiB;
constexpr size_t WS_MEMN = 232 * MiB, WS_KVB = 236 * MiB, WS_DT = 238 * MiB;
constexpr size_t WS_PROJ = 241 * MiB;
constexpr size_t WS_UA = 646 * MiB;
constexpr size_t WS_XC = 682 * MiB;
constexpr size_t WS_YS = 790 * MiB;
constexpr size_t WS_OATT = 862 * MiB;
constexpr size_t WS_T = 872 * MiB;
constexpr size_t WS_END = 944 * MiB;
constexpr int CW_TMO = 0, CW_CODE = 1, CW_BAR = 4096;

constexpr int RING_OFF = 0, RING_BYTES = 139264;
constexpr int LDSCTL_OFF = RING_BYTES, MISC_OFF = LDSCTL_OFF + 320;
constexpr int LDS_BYTES = 147456;
static_assert(MISC_OFF + 128 <= LDS_BYTES, "LDS map");

#define GAS __attribute__((address_space(1)))
#define LAS __attribute__((address_space(3)))
typedef unsigned short bf16;
typedef unsigned v4u __attribute__((ext_vector_type(4)));
typedef unsigned v2u __attribute__((ext_vector_type(2)));
typedef float f32x4 __attribute__((ext_vector_type(4)));
typedef short bf16x8 __attribute__((ext_vector_type(8)));
typedef GAS unsigned gu32;
typedef GAS unsigned long long gu64;
#define RLX_AGENT __ATOMIC_RELAXED, __HIP_MEMORY_SCOPE_AGENT
#define LDS_WAIT() asm volatile("s_waitcnt lgkmcnt(0)" ::: "memory")
#define VM_WAIT() asm volatile("s_waitcnt vmcnt(0)" ::: "memory")
__device__ __forceinline__ unsigned f2bf(float f) { unsigned u = __builtin_bit_cast(unsigned, f); return (u + 0x7fffu + ((u >> 16) & 1u)) >> 16; }
__device__ __forceinline__ unsigned pk2(float lo, float hi) { return f2bf(lo) | (f2bf(hi) << 16); }
__device__ __forceinline__ float bflo(unsigned w) { return __uint_as_float(w << 16); }
__device__ __forceinline__ float bfhi(unsigned w) { return __uint_as_float(w & 0xffff0000u); }
__device__ __forceinline__ void unpack8(const v4u w, float* f) { f[0] = bflo(w.x); f[1] = bfhi(w.x); f[2] = bflo(w.y); f[3] = bfhi(w.y); f[4] = bflo(w.z); f[5] = bfhi(w.z); f[6] = bflo(w.w); f[7] = bfhi(w.w); }
__device__ __forceinline__ v4u pack8(const float* f) { v4u w; w.x = pk2(f[0], f[1]); w.y = pk2(f[2], f[3]); w.z = pk2(f[4], f[5]); w.w = pk2(f[6], f[7]); return w; }
__device__ __forceinline__ float wave_sum(float v) {
#pragma unroll
    for (int o = 1; o < 64; o <<= 1) v += __shfl_xor(v, o);
    return v;
}

#define XB_TMO      128
#define XB_XCNT(j)  (256  + 64 * (j))
#define XB_XSUB(j)  (1280 + 64 * (j))
#define XB_XGEN(j)  (2304 + 64 * (j))
#define XB_TOP      3328
#define XB_TOPGEN   3392
#define XCD_BAR_WORDS 3456
#define XB_SPIN_CAP (1u << 18)
__device__ __forceinline__ unsigned xb_ld(unsigned* p)              { return __hip_atomic_load(p, __ATOMIC_RELAXED, __HIP_MEMORY_SCOPE_AGENT); }
__device__ __forceinline__ unsigned xb_add(unsigned* p, unsigned v) { return __hip_atomic_fetch_add(p, v, __ATOMIC_RELAXED, __HIP_MEMORY_SCOPE_AGENT); }
__device__ __forceinline__ unsigned xb_xcc_id() { return (unsigned)__builtin_amdgcn_s_getreg((3 << 11) | 20) & 0xFu; }
#define XB_SPIN(cond, bar) do { unsigned _sp = 0; while (cond) { __builtin_amdgcn_s_sleep(1); \
    if ((++_sp & 255u) == 0u) { if (xb_ld(&(bar)[XB_TMO])) break; if (_sp > XB_SPIN_CAP) { atomicAdd(&(bar)[XB_TMO], 1u); break; } } } } while (0)
struct XcdBarrier { unsigned* bar; unsigned x; volatile LAS unsigned* st; };
__device__ __forceinline__ XcdBarrier xcd_barrier_post(unsigned* bar, volatile LAS unsigned* st) {
    XcdBarrier b; b.bar = bar; b.x = xb_xcc_id(); b.st = st;
    if (threadIdx.x == 0) (void)xb_add(&bar[XB_XCNT(b.x)], 1u);
    return b;
}
__device__ __forceinline__ void xcd_barrier_complete(unsigned* bar, unsigned x, unsigned& nloc, unsigned& nx) {
    const unsigned G = gridDim.x * gridDim.y * gridDim.z;
    unsigned sum, cnt, mine, sp = 0u;
    for (;;) {
        sum = 0u; cnt = 0u; mine = 0u;
#pragma unroll
        for (unsigned j = 0; j < 16; ++j) { const unsigned c = xb_ld(&bar[XB_XCNT(j)]); sum += c; cnt += (c > 0u) ? 1u : 0u; mine = (j == x) ? c : mine; }
        if (sum == G) break;
        __builtin_amdgcn_s_sleep(1);
        if ((++sp & 255u) == 0u) { if (xb_ld(&bar[XB_TMO])) break; if (sp > XB_SPIN_CAP) { atomicAdd(&bar[XB_TMO], 1u); break; } }
    }
    nloc = mine > 0u ? mine : 1u; nx = cnt > 0u ? cnt : 1u;
}
__device__ __forceinline__ void xcd_barrier(const XcdBarrier& b) {
    asm volatile("s_waitcnt vmcnt(0)" ::: "memory");
    __syncthreads();
    if (threadIdx.x == 0) {
        unsigned* bar = b.bar;
        __builtin_amdgcn_s_waitcnt(0);
        unsigned nloc = b.st[0], nx = b.st[1];
        if (nloc == 0u) { xcd_barrier_complete(bar, b.x, nloc, nx); b.st[0] = nloc; b.st[1] = nx; }
        const unsigned old = xb_add(&bar[XB_XSUB(b.x)], 1u);
        const unsigned gen = old / nloc;
        if (old + 1u == (gen + 1u) * nloc) {
            __builtin_amdgcn_fence(__ATOMIC_RELEASE, "agent");
            asm volatile("s_waitcnt vmcnt(0)" ::: "memory");
            const unsigned og = xb_add(&bar[XB_TOP], 1u);
            const unsigned tg = og / nx;
            if (og + 1u == (tg + 1u) * nx) xb_add(&bar[XB_TOPGEN], 1u);
            else XB_SPIN(xb_ld(&bar[XB_TOPGEN]) == tg, bar);
            __builtin_amdgcn_fence(__ATOMIC_ACQUIRE, "agent");
            xb_add(&bar[XB_XGEN(b.x)], 1u);
            asm volatile("s_waitcnt vmcnt(0)" ::: "memory");
        } else {
            XB_SPIN(xb_ld(&bar[XB_XGEN(b.x)]) == gen, bar);
            __builtin_amdgcn_fence(__ATOMIC_ACQUIRE, "agent");
            asm volatile("s_waitcnt vmcnt(0)" ::: "memory");
        }
    }
    __syncthreads();
}

struct Args { const float* in[28]; float* out; unsigned char* ws; int ph_lo, ph_hi; };
enum { I_XP = 0, I_XS, I_MEM, I_CK, I_CV, I_SCA, I_SCB, I_SSM, I_NPRE, I_NPOST, I_NMPRE, I_NMPOST, I_NMEM, I_WIN, I_CAW, I_WOA, I_CBW, I_CBB, I_DTB, I_ALOG, I_DSK, I_SNW, I_WOB, I_WKV, I_WOX, I_WO, I_WF1, I_WF2 };

struct Frame {
    LAS unsigned char* lds;
    int tid, lane, wave, vcu, G;
};

__device__ __forceinline__ void p0_transpose_item(const float* W, int K, int N, bf16* WT, int k0, int n0, int drow, LAS float* scr, int lane) {
#pragma unroll 8
    for (int i = 0; i < 32; ++i) { const int kk = 2 * i + (lane >> 5); scr[kk * 33 + (lane & 31)] = W[(size_t)(k0 + kk) * N + n0 + (lane & 31)]; }
    LDS_WAIT(); asm volatile("" ::: "memory");
    const int c = lane & 7;
#pragma unroll
    for (int j = 0; j < 4; ++j) { const int n = (lane >> 3) + 8 * j; const LAS float* s = scr + (8 * c) * 33 + n;
        v4u o; o.x = pk2(s[0 * 33], s[1 * 33]); o.y = pk2(s[2 * 33], s[3 * 33]); o.z = pk2(s[4 * 33], s[5 * 33]); o.w = pk2(s[6 * 33], s[7 * 33]);
        *(GAS v4u*)(WT + (size_t)(drow + n) * K + k0 + 8 * c) = o; }
    LDS_WAIT(); asm volatile("" ::: "memory");
}
__device__ __forceinline__ int win_dest_row(int n0) {
    if (n0 < 16384) return n0;
    if (n0 < 16448) return C_DT + (n0 - 16384);
    if (n0 < 16960) return C_Q + (n0 - 16448);
    return C_G + (n0 - 16960);
}
__device__ __forceinline__ void rms_row_to_bf16(const float* xrow, const float* g, bf16* orow, int lane) {
    const GAS f32x4* xr = (const GAS f32x4*)xrow + lane;
    f32x4 v[8]; float s = 0.f;
#pragma unroll
    for (int j = 0; j < 8; ++j) { v[j] = xr[64 * j]; s += (v[j].x * v[j].x + v[j].y * v[j].y) + (v[j].z * v[j].z + v[j].w * v[j].w); }
    const float rs = 1.0f / sqrtf(wave_sum(s) * (1.f / DM) + EPS);
    const GAS f32x4* gr = (const GAS f32x4*)g + lane;
    GAS v2u* o8 = (GAS v2u*)orow + lane;
#pragma unroll
    for (int j = 0; j < 8; ++j) { const f32x4 gg = gr[64 * j]; v2u w; w.x = pk2(v[j].x * rs * gg.x, v[j].y * rs * gg.y); w.y = pk2(v[j].z * rs * gg.z, v[j].w * rs * gg.w); o8[64 * j] = w; }
}
__device__ __forceinline__ void phase_prologue(const Frame& F, const Args& a) {
    unsigned char* ws = a.ws;
    LAS float* scr = (LAS float*)(F.lds + RING_OFF + F.wave * 16384);
    const int gw = F.vcu * NWAVES + F.wave, NGW = F.G * NWAVES;
    constexpr int I_0 = 32 * 722, I_1 = I_0 + 32 * 64, I_2 = I_1 + 64 * 64, I_3 = I_2 + 8 * 64, I_4 = I_3 + 32 * 64, I_5 = I_4 + 32 * 256, I_6 = I_5 + 128 * 64, I_7 = I_6 + 32 * 32;
    for (int it = gw; it < I_7; it += NGW) {
        const float* W; int K, N, r; bf16* WT; bool win = false;
        if (it < I_0) { W = a.in[I_WIN]; K = 2048; N = 23104; r = it; WT = (bf16*)(ws + WS_WIN); win = true; }
        else if (it < I_1) { W = a.in[I_WOA]; K = 2048; N = 2048; r = it - I_0; WT = (bf16*)(ws + WS_WA); }
        else if (it < I_2) { W = a.in[I_WOB]; K = 4096; N = 2048; r = it - I_1; WT = (bf16*)(ws + WS_WB); }
        else if (it < I_3) { W = a.in[I_WOX]; K = 512; N = 2048; r = it - I_2; WT = (bf16*)(ws + WS_WX); }
        else if (it < I_4) { W = a.in[I_WO]; K = 2048; N = 2048; r = it - I_3; WT = (bf16*)(ws + WS_WO); }
        else if (it < I_5) { W = a.in[I_WF1]; K = 2048; N = 8192; r = it - I_4; WT = (bf16*)(ws + WS_W1); }
        else if (it < I_6) { W = a.in[I_WF2]; K = 8192; N = 2048; r = it - I_5; WT = (bf16*)(ws + WS_W2); }
        else { W = a.in[I_WKV]; K = 2048; N = 1024; r = it - I_6; WT = (bf16*)(ws + WS_WKV); }
        const int nblk = N / 32, kb = r / nblk, nb = r % nblk, n0 = 32 * nb;
        p0_transpose_item(W, K, N, WT, 64 * kb, n0, win ? win_dest_row(n0) : n0, scr, F.lane);
    }
    { GAS v4u* z = (GAS v4u*)(ws + WS_WIN + (size_t)23104 * 2048 * 2); const int n16 = 192 * 2048 * 2 / 16;
      for (int i = F.vcu * 512 + F.tid; i < n16; i += F.G * 512) z[i] = (v4u){0u, 0u, 0u, 0u}; }
    for (int m = gw; m < NTOK + NMEMROW; m += NGW) {
        if (m < NTOK) { const float* xr = m < NTOK_P ? a.in[I_XP] + (size_t)m * DM : a.in[I_XS] + (size_t)(m - NTOK_P) * DM;
            rms_row_to_bf16(xr, a.in[I_NPRE], (bf16*)(ws + WS_XN) + (size_t)m * DM, F.lane); }
        else { const int mm = m - NTOK; rms_row_to_bf16(a.in[I_MEM] + (size_t)mm * DM, a.in[I_NMEM], (bf16*)(ws + WS_MEMN) + (size_t)mm * DM, F.lane); }
    }
}

__device__ __forceinline__ void ld8f(const float* p, float* f) { const f32x4 a = *(const GAS f32x4*)p, b = *(const GAS f32x4*)(p + 4); f[0] = a.x; f[1] = a.y; f[2] = a.z; f[3] = a.w; f[4] = b.x; f[5] = b.y; f[6] = b.z; f[7] = b.w; }
__device__ __forceinline__ void st8f(float* p, const float* f) { *(GAS f32x4*)p = (f32x4){f[0], f[1], f[2], f[3]}; *(GAS f32x4*)(p + 4) = (f32x4){f[4], f[5], f[6], f[7]}; }
__device__ __forceinline__ void ld8bf(const bf16* p, float* f) { unpack8(*(const GAS v4u*)p, f); }
__device__ __forceinline__ void phase_conv(const Frame& F, const Args& a) {
    unsigned char* ws = a.ws;
    const bf16* P = (const bf16*)(ws + WS_PROJ); bf16* UA = (bf16*)(ws + WS_UA); bf16* XC = (bf16*)(ws + WS_XC);
    const long total = (long)NTOK * 1024;
    for (long idx = (long)F.vcu * 512 + F.tid; idx < total; idx += (long)F.G * 512) {
        const int row = (int)(idx >> 10), c = (int)(idx & 1023);
        int b, t, L; bool smp;
        if (row < NTOK_P) { b = row >> 11; t = row & 2047; L = SEQ_P; smp = false; } else { const int r2 = row - NTOK_P; b = r2 >> 3; t = r2 & 7; L = SEQ_S; smp = true; }
        if (c < 256) {
            const int ch = c * 8; float acc[8], vcur[8];
#pragma unroll
            for (int i = 0; i < 8; ++i) acc[i] = 0.f;
#pragma unroll
            for (int k = 0; k < 3; ++k) {
                float w[8], v[8]; ld8f(a.in[I_CAW] + k * 2048 + ch, w);
                const int ui = t + k;
                if (ui >= 2) { float ca[8], ha[8]; const bf16* pr = P + (size_t)(row + k - 2) * NPROJ; ld8bf(pr + C_CA + ch, ca); ld8bf(pr + C_HA + ch, ha);
#pragma unroll
                    for (int i = 0; i < 8; ++i) v[i] = ca[i] * ha[i]; }
                else if (smp) ld8f(a.in[I_SCA] + ((size_t)b * 2 + ui) * 2048 + ch, v);
                else {
#pragma unroll
                    for (int i = 0; i < 8; ++i) v[i] = 0.f; }
#pragma unroll
                for (int i = 0; i < 8; ++i) { acc[i] += w[i] * v[i]; if (k == 2) vcur[i] = v[i]; }
            }
            float ba[8], o[8]; ld8bf(P + (size_t)row * NPROJ + C_BA + ch, ba);
#pragma unroll
            for (int i = 0; i < 8; ++i) o[i] = ba[i] * acc[i];
            *(GAS v4u*)(UA + (size_t)row * 2048 + ch) = pack8(o);
            if (t >= L - 2) { const int j = t - (L - 2); st8f(a.out + (smp ? O_CAS : O_CAP) + ((size_t)b * 2 + j) * 2048 + ch, vcur); }
        } else {
            const int ch = (c - 256) * 8; float acc[8], xcur[8];
            ld8f(a.in[I_CBB] + ch, acc);
#pragma unroll
            for (int k = 0; k < 4; ++k) {
                float w[8], v[8]; ld8f(a.in[I_CBW] + k * 6144 + ch, w);
                const int ui = t + k;
                if (ui >= 3) ld8bf(P + (size_t)(row + k - 3) * NPROJ + C_XBC + ch, v);
                else if (smp) ld8f(a.in[I_SCB] + ((size_t)b * 3 + ui) * 6144 + ch, v);
                else {
#pragma unroll
                    for (int i = 0; i < 8; ++i) v[i] = 0.f; }
#pragma unroll
                for (int i = 0; i < 8; ++i) { acc[i] += w[i] * v[i]; if (k == 3) xcur[i] = v[i]; }
            }
            float o[8];
#pragma unroll
            for (int i = 0; i < 8; ++i) o[i] = acc[i] * __builtin_amdgcn_rcpf(1.0f + __expf(-acc[i]));
            *(GAS v4u*)(XC + (size_t)row * 6144 + ch) = pack8(o);
            if (t >= L - 3) { const int j = t - (L - 3); st8f(a.out + (smp ? O_CBS : O_CBP) + ((size_t)b * 3 + j) * 6144 + ch, xcur); }
        }
    }
}

template <bool SMP> __device__ __forceinline__ void ssd_seq_unit(const Frame& F, const Args& a, int b, int hd) {
    unsigned char* ws = a.ws;
    constexpr int L = SMP ? SEQ_S : SEQ_P, TB = SMP ? 8 : 64;
    const bf16* XC = (const bf16*)(ws + WS_XC); const float* DT = (const float*)(ws + WS_DT); bf16* YS = (bf16*)(ws + WS_YS);
    LAS float* Bs = (LAS float*)(F.lds + RING_OFF); LAS float* Cs = Bs + 64 * 128; LAS float* xs = Cs + 64 * 128; LAS float* ys = xs + 64 * 64; LAS float* dts = ys + 64 * 64;
    const int tid = F.tid, p = tid >> 3, ng = tid & 7, g = hd >> 3;
    const int row0 = SMP ? NTOK_P + b * SEQ_S : b * SEQ_P;
    const float A = -__expf(a.in[I_ALOG][hd]), Dk = a.in[I_DSK][hd];
    float h[16];
    if (SMP) { const float* hp = a.in[I_SSM] + (((size_t)b * NHEAD + hd) * HDIM + p) * DSTATE + ng * 16;
#pragma unroll
        for (int i = 0; i < 4; ++i) { const f32x4 v = *(const GAS f32x4*)(hp + 4 * i); h[4 * i] = v.x; h[4 * i + 1] = v.y; h[4 * i + 2] = v.z; h[4 * i + 3] = v.w; } }
    else {
#pragma unroll
        for (int i = 0; i < 16; ++i) h[i] = 0.f; }
    for (int t0 = 0; t0 < L; t0 += TB) {
        __syncthreads();
        for (int id = tid; id < TB * 16; id += 512) { const int r = id >> 4, cc = id & 15; const bf16* pr = XC + (size_t)(row0 + t0 + r) * 6144;
            float f[8]; ld8bf(pr + 4096 + g * 128 + cc * 8, f);
#pragma unroll
            for (int i = 0; i < 8; ++i) Bs[r * 128 + cc * 8 + i] = f[i];
            ld8bf(pr + 5120 + g * 128 + cc * 8, f);
#pragma unroll
            for (int i = 0; i < 8; ++i) Cs[r * 128 + cc * 8 + i] = f[i]; }
        for (int id = tid; id < TB * 8; id += 512) { const int r = id >> 3, cc = id & 7; float f[8]; ld8bf(XC + (size_t)(row0 + t0 + r) * 6144 + hd * 64 + cc * 8, f);
#pragma unroll
            for (int i = 0; i < 8; ++i) xs[r * 64 + cc * 8 + i] = f[i]; }
        if (tid < TB) dts[tid] = DT[(size_t)(row0 + t0 + tid) * 64 + hd];
        __syncthreads();
        for (int t = 0; t < TB; ++t) {
            const float dt = dts[t], dA = __expf(dt * A), xv = xs[t * 64 + p], dtx = dt * xv;
            float y = 0.f;
#pragma unroll
            for (int i = 0; i < 4; ++i) { const f32x4 bv = *(const LAS f32x4*)(Bs + t * 128 + ng * 16 + 4 * i), cv = *(const LAS f32x4*)(Cs + t * 128 + ng * 16 + 4 * i);
                h[4 * i] = h[4 * i] * dA + dtx * bv.x; h[4 * i + 1] = h[4 * i + 1] * dA + dtx * bv.y; h[4 * i + 2] = h[4 * i + 2] * dA + dtx * bv.z; h[4 * i + 3] = h[4 * i + 3] * dA + dtx * bv.w;
                y += h[4 * i] * cv.x + h[4 * i + 1] * cv.y + h[4 * i + 2] * cv.z + h[4 * i + 3] * cv.w; }
            y += __shfl_xor(y, 1); y += __shfl_xor(y, 2); y += __shfl_xor(y, 4);
            if (ng == 0) ys[t * 64 + p] = y + Dk * xv;
        }
        __syncthreads();
        for (int id = tid; id < TB * 8; id += 512) { const int r = id >> 3, cc = id & 7; float f[8];
#pragma unroll
            for (int i = 0; i < 8; ++i) f[i] = ys[r * 64 + cc * 8 + i];
            *(GAS v4u*)(YS + (size_t)(row0 + t0 + r) * 4096 + hd * 64 + cc * 8) = pack8(f); }
    }
    { float* hp = a.out + (SMP ? O_SSS : O_SSP) + (((size_t)b * NHEAD + hd) * HDIM + p) * DSTATE + ng * 16;
#pragma unroll
      for (int i = 0; i < 4; ++i) *(GAS f32x4*)(hp + 4 * i) = (f32x4){h[4 * i], h[4 * i + 1], h[4 * i + 2], h[4 * i + 3]}; }
}

constexpr int KS_STRIDE = 272, VT_STRIDE = 528;
template <bool SMP> __device__ __forceinline__ void attn_unit(const Frame& F, const Args& a, int b, int hh, int qb) {
    unsigned char* ws = a.ws;
    const bf16* P = (const bf16*)(ws + WS_PROJ); bf16* OA = (bf16*)(ws + WS_OATT);
    LAS unsigned char* Ks = F.lds + RING_OFF; LAS unsigned char* Vt = Ks + 256 * KS_STRIDE;
    const int tid = F.tid, lane = F.lane, wid = F.wave;
    __syncthreads();
    for (int id = tid; id < 256 * 16; id += 512) { const int key = id >> 4, cc = id & 15; float kf[8], vf[8]; v4u kw;
        if (SMP) { const size_t off = (((size_t)b * 256 + key) * 4 + hh) * 128 + cc * 8; ld8f(a.in[I_CK] + off, kf); ld8f(a.in[I_CV] + off, vf); kw = pack8(kf); }
        else { const bf16* kv = (const bf16*)(ws + WS_KVB) + ((size_t)b * 256 + key) * 1024 + hh * 128 + cc * 8; kw = *(const GAS v4u*)kv; ld8bf(kv + 512, vf); }
        *(LAS v4u*)(Ks + key * KS_STRIDE + cc * 16) = kw;
#pragma unroll
        for (int i = 0; i < 8; ++i) *(LAS unsigned short*)(Vt + (cc * 8 + i) * VT_STRIDE + key * 2) = (unsigned short)f2bf(vf[i]); }
    __syncthreads();
    if (SMP && wid != 0) return;
    const int fr = lane & 15, g = lane >> 4;
    const int qrow0 = SMP ? NTOK_P + b * SEQ_S : b * SEQ_P + qb * 128 + wid * 16;
    const int qr = SMP ? (fr & 7) : fr;
    bf16x8 qf[4];
#pragma unroll
    for (int ks = 0; ks < 4; ++ks) qf[ks] = *(const GAS bf16x8*)(P + (size_t)(qrow0 + qr) * NPROJ + C_Q + hh * 128 + ks * 32 + g * 8);
    f32x4 s[16];
#pragma unroll
    for (int blk = 0; blk < 16; ++blk) { s[blk] = (f32x4){0.f, 0.f, 0.f, 0.f};
#pragma unroll
        for (int ks = 0; ks < 4; ++ks) { const bf16x8 kf = *(const LAS bf16x8*)(Ks + (blk * 16 + fr) * KS_STRIDE + ks * 64 + g * 16);
            s[blk] = __builtin_amdgcn_mfma_f32_16x16x32_bf16(kf, qf[ks], s[blk], 0, 0, 0); } }
    const float sc = 0.08838834764831845f;
    float mx = -3.0e38f;
#pragma unroll
    for (int blk = 0; blk < 16; ++blk)
#pragma unroll
        for (int r = 0; r < 4; ++r) { s[blk][r] *= sc; mx = fmaxf(mx, s[blk][r]); }
    mx = fmaxf(mx, __shfl_xor(mx, 16)); mx = fmaxf(mx, __shfl_xor(mx, 32));
    float sum = 0.f;
#pragma unroll
    for (int blk = 0; blk < 16; ++blk)
#pragma unroll
        for (int r = 0; r < 4; ++r) { s[blk][r] = __expf(s[blk][r] - mx); sum += s[blk][r]; }
    sum += __shfl_xor(sum, 16); sum += __shfl_xor(sum, 32);
    const float inv = 1.0f / sum;
    bf16x8 pf[8];
#pragma unroll
    for (int k2 = 0; k2 < 8; ++k2) { v4u w; w.x = pk2(s[2 * k2][0] * inv, s[2 * k2][1] * inv); w.y = pk2(s[2 * k2][2] * inv, s[2 * k2][3] * inv);
        w.z = pk2(s[2 * k2 + 1][0] * inv, s[2 * k2 + 1][1] * inv); w.w = pk2(s[2 * k2 + 1][2] * inv, s[2 * k2 + 1][3] * inv); pf[k2] = __builtin_bit_cast(bf16x8, w); }
#pragma unroll
    for (int db = 0; db < 8; ++db) { f32x4 o = (f32x4){0.f, 0.f, 0.f, 0.f};
#pragma unroll
        for (int k2 = 0; k2 < 8; ++k2) { const LAS unsigned char* vp = Vt + (db * 16 + fr) * VT_STRIDE + (k2 * 32 + 4 * g) * 2;
            const v2u lo = *(const LAS v2u*)vp, hi = *(const LAS v2u*)(vp + 32);
            const v4u vw = (v4u){lo.x, lo.y, hi.x, hi.y};
            o = __builtin_amdgcn_mfma_f32_16x16x32_bf16(__builtin_bit_cast(bf16x8, vw), pf[k2], o, 0, 0, 0); }
        if (!SMP || fr < 8) { v2u w; w.x = pk2(o[0], o[1]); w.y = pk2(o[2], o[3]); *(GAS v2u*)(OA + (size_t)(qrow0 + fr) * D_XATT + hh * 128 + db * 16 + 4 * g) = w; } }
}

__device__ __forceinline__ void phase_gnorm(const Frame& F, const Args& a) {
    unsigned char* ws = a.ws;
    const bf16* P = (const bf16*)(ws + WS_PROJ); bf16* YS = (bf16*)(ws + WS_YS);
    const int gw = F.vcu * NWAVES + F.wave, NGW = F.G * NWAVES;
    for (int it = gw; it < NTOK * NGRP; it += NGW) { const int row = it >> 3, g = it & 7, col = g * 512 + F.lane * 8;
        float y[8], z[8], w[8]; ld8bf(YS + (size_t)row * 4096 + col, y); ld8bf(P + (size_t)row * NPROJ + C_Z + col, z); ld8f(a.in[I_SNW] + col, w);
        float ss = 0.f;
#pragma unroll
        for (int i = 0; i < 8; ++i) { y[i] = y[i] * z[i] * __builtin_amdgcn_rcpf(1.0f + __expf(-z[i])); ss += y[i] * y[i]; }
        const float rs = 1.0f / sqrtf(wave_sum(ss) * (1.f / 512.f) + EPS);
#pragma unroll
        for (int i = 0; i < 8; ++i) y[i] = y[i] * rs * w[i];
        *(GAS v4u*)(YS + (size_t)row * 4096 + col) = pack8(y); }
}

__device__ __forceinline__ void phase_res1(const Frame& F, const Args& a) {
    unsigned char* ws = a.ws;
    const float* MX = (const float*)(ws + WS_YS); bf16* HN = (bf16*)(ws + WS_XN);
    const int gw = F.vcu * NWAVES + F.wave, NGW = F.G * NWAVES;
    for (int m = gw; m < NTOK; m += NGW) {
        const float* xr = m < NTOK_P ? a.in[I_XP] + (size_t)m * DM : a.in[I_XS] + (size_t)(m - NTOK_P) * DM;
        const GAS f32x4* mr = (const GAS f32x4*)(MX + (size_t)m * DM) + F.lane; const GAS f32x4* xv = (const GAS f32x4*)xr + F.lane;
        const GAS f32x4* g1 = (const GAS f32x4*)a.in[I_NPOST] + F.lane; const GAS f32x4* g2 = (const GAS f32x4*)a.in[I_NMPRE] + F.lane;
        f32x4 v[8]; float s = 0.f;
#pragma unroll
        for (int j = 0; j < 8; ++j) { v[j] = mr[64 * j]; s += (v[j].x * v[j].x + v[j].y * v[j].y) + (v[j].z * v[j].z + v[j].w * v[j].w); }
        const float rs = 1.0f / sqrtf(wave_sum(s) * (1.f / DM) + EPS);
        float s2 = 0.f;
        GAS f32x4* o = (GAS f32x4*)(a.out + O_Y + (size_t)m * DM) + F.lane;
#pragma unroll
        for (int j = 0; j < 8; ++j) { v[j] = xv[64 * j] + v[j] * rs * g1[64 * j]; o[64 * j] = v[j]; s2 += (v[j].x * v[j].x + v[j].y * v[j].y) + (v[j].z * v[j].z + v[j].w * v[j].w); }
        const float rs2 = 1.0f / sqrtf(wave_sum(s2) * (1.f / DM) + EPS);
        GAS v2u* o8 = (GAS v2u*)(HN + (size_t)m * DM) + F.lane;
#pragma unroll
        for (int j = 0; j < 8; ++j) { const f32x4 gg = g2[64 * j]; v2u w; w.x = pk2(v[j].x * rs2 * gg.x, v[j].y * rs2 * gg.y); w.y = pk2(v[j].z * rs2 * gg.z, v[j].w * rs2 * gg.w); o8[64 * j] = w; }
    }
}
__device__ __forceinline__ void phase_res2(const Frame& F, const Args& a) {
    unsigned char* ws = a.ws;
    const float* FFB = (const float*)(ws + WS_T);
    const int gw = F.vcu * NWAVES + F.wave, NGW = F.G * NWAVES;
    for (int m = gw; m < NTOK; m += NGW) {
        const GAS f32x4* fr_ = (const GAS f32x4*)(FFB + (size_t)m * DM) + F.lane; const GAS f32x4* g1 = (const GAS f32x4*)a.in[I_NMPOST] + F.lane;
        GAS f32x4* o = (GAS f32x4*)(a.out + O_Y + (size_t)m * DM) + F.lane;
        f32x4 v[8]; float s = 0.f;
#pragma unroll
        for (int j = 0; j < 8; ++j) { v[j] = fr_[64 * j]; s += (v[j].x * v[j].x + v[j].y * v[j].y) + (v[j].z * v[j].z + v[j].w * v[j].w); }
        const float rs = 1.0f / sqrtf(wave_sum(s) * (1.f / DM) + EPS);
#pragma unroll
        for (int j = 0; j < 8; ++j) o[64 * j] = o[64 * j] + v[j] * rs * g1[64 * j];
    }
}

__global__ void __launch_bounds__(NWAVES * 64, 2) fwd(Args args) {
    extern __shared__ __attribute__((aligned(16))) unsigned char lds[];
    Frame F;
    F.lds = (LAS unsigned char*)lds;
    volatile LAS unsigned* MISC = (volatile LAS unsigned*)(F.lds + MISC_OFF);
    F.tid = threadIdx.x; F.lane = F.tid & 63; F.wave = __builtin_amdgcn_readfirstlane(F.tid >> 6);
    F.G = gridDim.x; { const int bx = blockIdx.x; F.vcu = (F.G % 8 == 0) ? (bx % 8) * (F.G / 8) + bx / 8 : bx; }
    unsigned char* ws = args.ws;
    gu32* ctl = (gu32*)(ws + WS_CTL);
    for (int u = F.tid; u < (LDS_BYTES - LDSCTL_OFF) / 4; u += NWAVES * 64) ((LAS unsigned*)(F.lds + LDSCTL_OFF))[u] = 0u;
    __syncthreads();
    XcdBarrier bar; bar.bar = (unsigned*)(ctl + CW_BAR); bar.x = 0; bar.st = nullptr;
    if (!MK_PER_PHASE) bar = xcd_barrier_post((unsigned*)(ctl + CW_BAR), MISC + 8);
    const int lo = args.ph_lo, hi = args.ph_hi;
#define IN(k) (lo <= (k) && (k) < hi)
#define SEAM(k) do { if (IN(k) && IN((k) + 1)) xcd_barrier(bar); } while (0)
    const int G = F.G, cu = (int)blockIdx.x;

    if (IN(0)) { phase_prologue(F, args); } SEAM(0);

    if (IN(1)) {
        { pg8::Gemm g{(const pg8::bf16_t*)(ws + WS_XN), (const pg8::bf16_t*)(ws + WS_WIN), NTOK, NPAD, DM}; pg8::StaticOrder S; S.init(NTOK, NPAD, G, cu);
          pg8::EpiProj E{(pg8::bf16_t*)(ws + WS_PROJ), (float*)(ws + WS_DT), args.in[I_DTB]};
          pg8::gemm_phase<pg8::EpiProj, pg8::StaticOrder, true, true>(F.lds + RING_OFF, g, S, E); }
        { pg8::Gemm g{(const pg8::bf16_t*)(ws + WS_MEMN), (const pg8::bf16_t*)(ws + WS_WKV), NMEMROW, 1024, DM}; pg8::StaticOrder S; S.init(NMEMROW, 1024, G, cu);
          pg8::EpiKV E{args.out + O_MK, args.out + O_MV, (pg8::bf16_t*)(ws + WS_KVB)};
          pg8::gemm_phase<pg8::EpiKV, pg8::StaticOrder, true, true>(F.lds + RING_OFF, g, S, E); }
    } SEAM(1);

    if (IN(2)) { phase_conv(F, args); } SEAM(2);

    if (IN(3)) {
        for (int u = F.vcu; u < NB_P * NHEAD; u += G) ssd_seq_unit<false>(F, args, u >> 6, u & 63);
        for (int u = F.vcu; u < NB_S * NHEAD; u += G) ssd_seq_unit<true>(F, args, u >> 6, u & 63);
        for (int u = F.vcu; u < NB_P * 4 * 16; u += G) attn_unit<false>(F, args, u >> 6, (u >> 4) & 3, u & 15);
        for (int u = F.vcu; u < NB_S * 4; u += G) attn_unit<true>(F, args, u >> 2, u & 3, 0);
        __syncthreads();
    } SEAM(3);

    if (IN(4)) { phase_gnorm(F, args); } SEAM(4);

    if (IN(5)) {
        const pg8::bf16_t* Pj = (const pg8::bf16_t*)(ws + WS_PROJ);
        { pg8::Gemm g{(const pg8::bf16_t*)(ws + WS_UA), (const pg8::bf16_t*)(ws + WS_WA), NTOK, DM, 2048}; pg8::StaticOrder S; S.init(NTOK, DM, G, cu);
          pg8::EpiGate<0> E{(float*)(ws + WS_T), Pj, C_G, nullptr}; pg8::gemm_phase<pg8::EpiGate<0>, pg8::StaticOrder, true, true>(F.lds + RING_OFF, g, S, E); }
        { pg8::Gemm g{(const pg8::bf16_t*)(ws + WS_YS), (const pg8::bf16_t*)(ws + WS_WB), NTOK, DM, 4096}; pg8::StaticOrder S; S.init(NTOK, DM, G, cu);
          pg8::EpiGate<1> E{(float*)(ws + WS_T), Pj, C_G + 2048, nullptr}; pg8::gemm_phase<pg8::EpiGate<1>, pg8::StaticOrder, true, true>(F.lds + RING_OFF, g, S, E); }
        { pg8::Gemm g{(const pg8::bf16_t*)(ws + WS_OATT), (const pg8::bf16_t*)(ws + WS_WX), NTOK, DM, 512}; pg8::StaticOrder S; S.init(NTOK, DM, G, cu);
          pg8::EpiGate<2> E{(float*)(ws + WS_T), Pj, C_G + 4096, (pg8::bf16_t*)(ws + WS_XN)}; pg8::gemm_phase<pg8::EpiGate<2>, pg8::StaticOrder, true, true>(F.lds + RING_OFF, g, S, E); }
    } SEAM(5);

    if (IN(6)) {
        pg8::Gemm g{(const pg8::bf16_t*)(ws + WS_XN), (const pg8::bf16_t*)(ws + WS_WO), NTOK, DM, DM}; pg8::StaticOrder S; S.init(NTOK, DM, G, cu);
        pg8::EpiF32 E{(float*)(ws + WS_YS), DM}; pg8::gemm_phase<pg8::EpiF32, pg8::StaticOrder, true, true>(F.lds + RING_OFF, g, S, E);
    } SEAM(6);

    if (IN(7)) { phase_res1(F, args); } SEAM(7);

    if (IN(8)) {
        pg8::Gemm g{(const pg8::bf16_t*)(ws + WS_XN), (const pg8::bf16_t*)(ws + WS_W1), NTOK, DFF, DM}; pg8::StaticOrder S; S.init(NTOK, DFF, G, cu);
        pg8::EpiRelu2 E{(pg8::bf16_t*)(ws + WS_PROJ), DFF}; pg8::gemm_phase<pg8::EpiRelu2, pg8::StaticOrder, true, true>(F.lds + RING_OFF, g, S, E);
    } SEAM(8);

    if (IN(9)) {
        pg8::Gemm g{(const pg8::bf16_t*)(ws + WS_PROJ), (const pg8::bf16_t*)(ws + WS_W2), NTOK, DM, DFF}; pg8::StaticOrder S; S.init(NTOK, DM, G, cu);
        pg8::EpiF32 E{(float*)(ws + WS_T), DM}; pg8::gemm_phase<pg8::EpiF32, pg8::StaticOrder, true, true>(F.lds + RING_OFF, g, S, E);
    } SEAM(9);

    if (IN(10)) { phase_res2(F, args); }
#undef IN
#undef SEAM
}

extern "C" void kernel_launch(void* const* d_in, const int* in_sizes, int n_in, void* d_out, int out_size, void* d_ws, size_t ws_size, hipStream_t stream) {
    static int grid = 0;
    if (grid == 0) {
        if (n_in != 28 || ws_size < WS_END) { fprintf(stderr, "kernel_launch: built for 28 inputs and >= %zu bytes of workspace; got n_in %d, ws %zu; nothing launched\n", (size_t)WS_END, n_in, ws_size); grid = -1; return; }
        int dev = 0, cus = 0, per_cu = 0;
        if (hipGetDevice(&dev) != hipSuccess || hipDeviceGetAttribute(&cus, hipDeviceAttributeMultiprocessorCount, dev) != hipSuccess) { grid = -1; return; }
        if (hipFuncSetAttribute((const void*)fwd, hipFuncAttributeMaxDynamicSharedMemorySize, LDS_BYTES) != hipSuccess) { fprintf(stderr, "kernel_launch: hipFuncSetAttribute failed\n"); grid = -1; return; }
        if (hipOccupancyMaxActiveBlocksPerMultiprocessor(&per_cu, (const void*)fwd, NWAVES * 64, LDS_BYTES) != hipSuccess || per_cu < 1)
            fprintf(stderr, "kernel_launch: note: occupancy query reports %d workgroups per CU\n", per_cu);
        (void)hipGetLastError();
        grid = cus;
    }
    if (grid < 0) return;
    if (hipMemsetAsync((char*)d_ws + WS_CTL, 0, CTL_ZERO_BYTES, stream) != hipSuccess) { fprintf(stderr, "kernel_launch: hipMemsetAsync failed\n"); return; }
    Args a{};
    for (int i = 0; i < 28; ++i) a.in[i] = (const float*)d_in[i];
    a.out = (float*)d_out; a.ws = (unsigned char*)d_ws;
#if MK_PER_PHASE
    for (int p = 0; p < N_PHASES; ++p) { a.ph_lo = p; a.ph_hi = p + 1; hipLaunchKernelGGL(fwd, dim3(grid), dim3(NWAVES * 64), LDS_BYTES, stream, a); }
#else
    a.ph_lo = 0; a.ph_hi = N_PHASES;
    hipLaunchKernelGGL(fwd, dim3(grid), dim3(NWAVES * 64), LDS_BYTES, stream, a);
#endif
    const hipError_t le = hipPeekAtLastError();
    if (le != hipSuccess) fprintf(stderr, "kernel_launch: launch failed: %s\n", hipGetErrorName(le));
}
```

```cpp
#include <hip/hip_runtime.h>
#include <cstdio>
#include <cstdint>

constexpr int DM = 2048, NTOK_P = 8192, NTOK_S = 1024, NTOK = 9216, NMEMROW = 1024;
constexpr int SEQ_P = 2048, SEQ_S = 8, NB_P = 4, NB_S = 128;
constexpr int D_INNER = 4096, D_XBC = 6144, NHEAD = 64, HDIM = 64, NGRP = 8, DSTATE = 128, DFF = 8192, D_XATT = 512;
constexpr int C_BA = 0, C_CA = 2048, C_HA = 4096, C_Z = 6144, C_XBC = 10240, C_Q = 16384, C_G = 16896, C_DT = 23040;
constexpr int NPROJ = 23040, NPAD = 23296;
constexpr float EPS = 1e-6f;
constexpr size_t O_Y = 0, O_MK = 18874368, O_MV = 19398656, O_CAP = 19922944, O_CBP = 19939328, O_SSP = 20013056, O_CAS = 22110208, O_CBS = 22634496, O_SSS = 24993792;

namespace pg8 {
#define PG8_LAS __attribute__((address_space(3)))
typedef unsigned short bf16_t;
typedef short bf16x8 __attribute__((ext_vector_type(8)));
typedef float f32x4 __attribute__((ext_vector_type(4)));
typedef unsigned u32x4 __attribute__((ext_vector_type(4)));
typedef unsigned u32x2 __attribute__((ext_vector_type(2)));
constexpr int BM = 256, BK = 64, HALF = 128, HTB = HALF * BK * 2  , STAGE_BYTES = 8 * HTB, NXCD = 8, WGM = 8;

__host__ __device__ __forceinline__ int lds_byte(int r, int c) { const int st = (r >> 4) * 2 + (c >> 5), rr = r & 15, cc = c & 31, ob = rr * 64 + cc * 2; return st * 1024 + (ob ^ (((ob >> 9) & 1) << 5)); }
__host__ __device__ __forceinline__ void stage_rc(int b, int& R, int& C) { const int st = b / 1024, sb = b % 1024, swz = sb ^ (((sb >> 9) & 1) << 5); R = (st >> 1) * 16 + swz / 64; C = (st & 1) * 32 + (swz % 64) / 2; }
__host__ __device__ __forceinline__ int perm32(int rho) { const int n = rho >> 4, i = rho & 15; return 8 * (i >> 2) + 4 * n + (i & 3); }

struct Unit { int pm, pn, k0, nt, mode, aux, keep; };
struct Gemm { const bf16_t* A; const bf16_t* Bt; int ld; };

struct StaticOrder {
    int nM, nN, nwg, G, c, nt;
    __host__ __device__ void init(int M, int N, int K, int G_, int c_) { nM = M / BM; nN = N / BM; nwg = nM * nN; G = G_; c = c_; nt = K / BK; }
    __host__ __device__ bool next(int i, Unit& u) const {
        const long L = (long)i * G + c; if (L >= nwg) return false;
        int wgid = (int)L; { const int q = nwg / NXCD, r = nwg % NXCD, xcd = wgid % NXCD, off = wgid / NXCD; wgid = (xcd < r ? xcd * (q + 1) : r * (q + 1) + (xcd - r) * q) + off; }
        const int nig = WGM * nN, gid = wgid / nig, fm = gid * WGM, gsz = (nM - fm) < WGM ? (nM - fm) : WGM;
        u.pm = fm + ((wgid % nig) % gsz); u.pn = (wgid % nig) / gsz; u.k0 = 0; u.nt = nt; u.mode = 0; u.aux = 0; u.keep = 0; return true;
    }
};

__device__ __forceinline__ unsigned cvt_pk_bf16(float lo, float hi) { unsigned r; asm volatile("v_cvt_pk_bf16_f32 %0, %1, %2" : "=v"(r) : "v"(lo), "v"(hi)); return r; }
__device__ __forceinline__ float bf_lo(unsigned w) { return __uint_as_float(w << 16); }
__device__ __forceinline__ float bf_hi(unsigned w) { return __uint_as_float(w & 0xffff0000u); }
__device__ __forceinline__ float sigmoidf_(float x) { return __builtin_amdgcn_rcpf(1.0f + __expf(-x)); }
__device__ __forceinline__ void unpack8(const u32x4 w, float* f) { f[0] = bf_lo(w.x); f[1] = bf_hi(w.x); f[2] = bf_lo(w.y); f[3] = bf_hi(w.y); f[4] = bf_lo(w.z); f[5] = bf_hi(w.z); f[6] = bf_lo(w.w); f[7] = bf_hi(w.w); }

typedef f32x4 Acc[2][2][4][2];

struct EpiProj {
    bf16_t* P; float* DT; const float* dt_bias;
    __device__ __forceinline__ void operator()(Acc& acc, const Unit& u, int wr, int wc, int fr, int fq) const {
        const int row0 = u.pm * BM + wr * 64 + fr, colt = u.pn * BM;
        if (colt < C_DT) {
            const bool gate = colt >= C_G;
            const int col0 = colt + wc * 32 + 8 * fq;
#pragma unroll
            for (int ai = 0; ai < 2; ++ai)
#pragma unroll
                for (int m = 0; m < 4; ++m) { bf16_t* rowp = P + (size_t)(row0 + ai * HALF + m * 16) * NPROJ + col0;
#pragma unroll
                    for (int bj = 0; bj < 2; ++bj) { f32x4 v0 = acc[ai][bj][m][0], v1 = acc[ai][bj][m][1];
                        if (gate) {
#pragma unroll
                            for (int i = 0; i < 4; ++i) { v0[i] = sigmoidf_(v0[i]); v1[i] = sigmoidf_(v1[i]); } }
                        u32x4 w; w.x = cvt_pk_bf16(v0[0], v0[1]); w.y = cvt_pk_bf16(v0[2], v0[3]); w.z = cvt_pk_bf16(v1[0], v1[1]); w.w = cvt_pk_bf16(v1[2], v1[3]);
                        *(u32x4*)(rowp + bj * HALF) = w; } }
        } else if (wc < 2) {
            const int c0 = wc * 32 + 8 * fq;
#pragma unroll
            for (int ai = 0; ai < 2; ++ai)
#pragma unroll
                for (int m = 0; m < 4; ++m) { float* rowp = DT + (size_t)(row0 + ai * HALF + m * 16) * 64 + c0;
#pragma unroll
                    for (int n = 0; n < 2; ++n) { f32x4 v = acc[ai][0][m][n]; const f32x4 bv = *(const f32x4*)(dt_bias + c0 + 4 * n);
#pragma unroll
                        for (int i = 0; i < 4; ++i) { const float x = v[i] + bv[i]; v[i] = x > 20.f ? x : log1pf(__expf(x)); }
                        *(f32x4*)(rowp + 4 * n) = v; } }
        }
    }
};
struct EpiRelu2 {
    bf16_t* O; int ldc;
    __device__ __forceinline__ void operator()(Acc& acc, const Unit& u, int wr, int wc, int fr, int fq) const {
        const int row0 = u.pm * BM + wr * 64 + fr, col0 = u.pn * BM + wc * 32 + 8 * fq;
#pragma unroll
        for (int ai = 0; ai < 2; ++ai)
#pragma unroll
            for (int m = 0; m < 4; ++m) { bf16_t* rowp = O + (size_t)(row0 + ai * HALF + m * 16) * ldc + col0;
#pragma unroll
                for (int bj = 0; bj < 2; ++bj) { f32x4 v0 = acc[ai][bj][m][0], v1 = acc[ai][bj][m][1];
#pragma unroll
                    for (int i = 0; i < 4; ++i) { const float a = fmaxf(v0[i], 0.f), b = fmaxf(v1[i], 0.f); v0[i] = a * a; v1[i] = b * b; }
                    u32x4 w; w.x = cvt_pk_bf16(v0[0], v0[1]); w.y = cvt_pk_bf16(v0[2], v0[3]); w.z = cvt_pk_bf16(v1[0], v1[1]); w.w = cvt_pk_bf16(v1[2], v1[3]);
                    *(u32x4*)(rowp + bj * HALF) = w; } }
    }
};
struct EpiKV {
    float* OK; float* OV; bf16_t* KVB;
    __device__ __forceinline__ void operator()(Acc& acc, const Unit& u, int wr, int wc, int fr, int fq) const {
        const int row0 = u.pm * BM + wr * 64 + fr, col0 = u.pn * BM + wc * 32 + 8 * fq;
#pragma unroll
        for (int ai = 0; ai < 2; ++ai)
#pragma unroll
            for (int m = 0; m < 4; ++m) { const int row = row0 + ai * HALF + m * 16;
#pragma unroll
                for (int bj = 0; bj < 2; ++bj) { const int col = col0 + bj * HALF; const f32x4 v0 = acc[ai][bj][m][0], v1 = acc[ai][bj][m][1];
                    float* dst = col < 512 ? OK + (size_t)row * 512 + col : OV + (size_t)row * 512 + (col - 512);
                    *(f32x4*)dst = v0; *(f32x4*)(dst + 4) = v1;
                    u32x4 w; w.x = cvt_pk_bf16(v0[0], v0[1]); w.y = cvt_pk_bf16(v0[2], v0[3]); w.z = cvt_pk_bf16(v1[0], v1[1]); w.w = cvt_pk_bf16(v1[2], v1[3]);
                    *(u32x4*)(KVB + (size_t)row * 1024 + col) = w; } }
    }
};
enum { MODE_OUT = 0, MODE_SLAB = 1, MODE_MID = 2 };
struct EpiF32 {
    float* C; int ldc; float* SLAB;
    __device__ __forceinline__ void operator()(Acc& acc, const Unit& u, int wr, int wc, int fr, int fq) const {
        const bool slab = u.mode == MODE_SLAB;
        float* base = slab ? SLAB + (size_t)u.aux * 65536 + (size_t)(wr * 64 + fr) * 256 + wc * 32 + 8 * fq : C + (size_t)(u.pm * BM + wr * 64 + fr) * ldc + u.pn * BM + wc * 32 + 8 * fq;
        const int ld = slab ? 256 : ldc;
#pragma unroll
        for (int ai = 0; ai < 2; ++ai)
#pragma unroll
            for (int m = 0; m < 4; ++m) { float* rowp = base + (size_t)(ai * HALF + m * 16) * ld;
#pragma unroll
                for (int bj = 0; bj < 2; ++bj) { *(f32x4*)(rowp + bj * HALF) = acc[ai][bj][m][0]; *(f32x4*)(rowp + bj * HALF + 4) = acc[ai][bj][m][1]; } }
    }
};
struct EpiMix {
    const bf16_t* P; bf16_t* OUT; float* SLAB;
    __device__ __forceinline__ void operator()(Acc& acc, const Unit& u, int wr, int wc, int fr, int fq) const {
        const int seg = u.aux >> 16, sl = u.aux & 0xffff, mode = u.mode;
        const int row0 = u.pm * BM + wr * 64 + fr, col0 = u.pn * BM + wc * 32 + 8 * fq;
#pragma unroll
        for (int ai = 0; ai < 2; ++ai)
#pragma unroll
            for (int m = 0; m < 4; ++m) { const int row = row0 + ai * HALF + m * 16; const bf16_t* gp = P + (size_t)row * NPROJ + C_G + seg * 2048 + col0;
#pragma unroll
                for (int bj = 0; bj < 2; ++bj) { float g[8]; unpack8(*(const u32x4*)(gp + bj * HALF), g);
                    if (mode == MODE_MID) { float g2[8]; unpack8(*(const u32x4*)(gp + 2048 + bj * HALF), g2);
#pragma unroll
                        for (int i = 0; i < 8; ++i) g[i] = g[i] * __builtin_amdgcn_rcpf(fmaxf(g2[i], 1e-20f)); }
                    f32x4 v0 = acc[ai][bj][m][0], v1 = acc[ai][bj][m][1];
#pragma unroll
                    for (int i = 0; i < 4; ++i) { v0[i] *= g[i]; v1[i] *= g[4 + i]; }
                    if (mode == MODE_MID) { acc[ai][bj][m][0] = v0; acc[ai][bj][m][1] = v1; }
                    else if (mode == MODE_OUT) { u32x4 w; w.x = cvt_pk_bf16(v0[0], v0[1]); w.y = cvt_pk_bf16(v0[2], v0[3]); w.z = cvt_pk_bf16(v1[0], v1[1]); w.w = cvt_pk_bf16(v1[2], v1[3]);
                        *(u32x4*)(OUT + (size_t)row * DM + col0 + bj * HALF) = w; }
                    else { float* sp = SLAB + (size_t)sl * 65536 + (size_t)(wr * 64 + fr + ai * HALF + m * 16) * 256 + wc * 32 + 8 * fq + bj * HALF; *(f32x4*)sp = v0; *(f32x4*)(sp + 4) = v1; } } }
    }
};

template <class Epi, class Sched>
__device__ __forceinline__ void gemm_phase(PG8_LAS unsigned char* lds, const Gemm g, const Sched& S, const Epi& E) {
    const int tid = threadIdx.x, wid = __builtin_amdgcn_readfirstlane(tid >> 6), lane = tid & 63, wr = wid >> 2, wc = wid & 3, fr = lane & 15, fq = lane >> 4;
    const int ld = g.ld;
    unsigned voffA[2], voffB[2];
#pragma unroll
    for (int i = 0; i < 2; ++i) { int R, C; stage_rc(tid * 16 + i * 8192, R, C); const int Rb = (R & ~31) + perm32(R & 31);
        voffA[i] = (unsigned)(R * ld + C) * 2u; voffB[i] = (unsigned)(Rb * ld + C) * 2u; }
    const size_t kstep = (size_t)(BK * 2);
    const size_t hstep = (size_t)HALF * ld * 2;
    const size_t tstep = 2 * hstep;
    const unsigned ldsw = (unsigned)wid * 1024u;
    const int aoff = lds_byte(wr * 64 + fr, fq * 8), boff = lds_byte(wc * 32 + fr, fq * 8);
#define PG8_SA(b, h) (((b) * 2 + (h)) * HTB)
#define PG8_SB(b, h) ((4 + (b) * 2 + (h)) * HTB)
#define PG8_STAGE(bufoff, gbase, voff) do { _Pragma("unroll") for (int _i = 0; _i < 2; ++_i) \
        __builtin_amdgcn_global_load_lds((const unsigned*)((const char*)(gbase) + (voff)[_i]), (PG8_LAS unsigned*)(lds + (bufoff) + ldsw + _i * 8192), 16, 0, 0); } while (0)
#define PG8_LDA(dst, b, h) do { _Pragma("unroll") for (int m = 0; m < 4; ++m) _Pragma("unroll") for (int k = 0; k < 2; ++k) dst[m][k] = *(const PG8_LAS bf16x8*)(lds + PG8_SA(b, h) + aoff + m * 2048 + k * 1024); } while (0)
#define PG8_LDB(dst, b, h) do { _Pragma("unroll") for (int n = 0; n < 2; ++n) _Pragma("unroll") for (int k = 0; k < 2; ++k) dst[n][k] = *(const PG8_LAS bf16x8*)(lds + PG8_SB(b, h) + boff + n * 2048 + k * 1024); } while (0)
#define PG8_MMA(ai, bj, At, Bt) do { __builtin_amdgcn_s_setprio(1); _Pragma("unroll") for (int m = 0; m < 4; ++m) _Pragma("unroll") for (int n = 0; n < 2; ++n) _Pragma("unroll") for (int k = 0; k < 2; ++k) \
        acc[ai][bj][m][n] = __builtin_amdgcn_mfma_f32_16x16x32_bf16(Bt[n][k], At[m][k], acc[ai][bj][m][n], 0, 0, 0); __builtin_amdgcn_s_setprio(0); } while (0)
#define PG8_WAIT_V(n) asm volatile("s_waitcnt vmcnt(" #n ")" ::: "memory")
#define PG8_WAIT_L(n) asm volatile("s_waitcnt lgkmcnt(" #n ")" ::: "memory")
#define PG8_BAR __builtin_amdgcn_s_barrier()
#define PG8_SCHED __builtin_amdgcn_sched_barrier(0)
    Unit cur, nxt; int ui = 0;
    if (!S.next(0, cur)) return;
    Acc acc;
#pragma unroll
    for (int a = 0; a < 2; ++a)
#pragma unroll
        for (int b = 0; b < 2; ++b)
#pragma unroll
            for (int m = 0; m < 4; ++m)
#pragma unroll
                for (int n = 0; n < 2; ++n) acc[a][b][m][n] = (f32x4){0.f, 0.f, 0.f, 0.f};
    bf16x8 At[4][2], B0[2][2], B1[2][2];
    const char* cA = (const char*)g.A + (size_t)cur.pm * tstep + (size_t)cur.k0 * kstep; const char* cB = (const char*)g.Bt + (size_t)cur.pn * tstep + (size_t)cur.k0 * kstep;
    PG8_STAGE(PG8_SB(0, 0), cB, voffB); PG8_STAGE(PG8_SB(0, 1), cB + hstep, voffB); PG8_STAGE(PG8_SA(0, 0), cA, voffA); PG8_STAGE(PG8_SA(0, 1), cA + hstep, voffA);
    if (wr == 1) PG8_BAR;
    PG8_WAIT_V(2); PG8_BAR;
    PG8_STAGE(PG8_SB(1, 0), cB + kstep, voffB); PG8_STAGE(PG8_SA(1, 0), cA + kstep, voffA); PG8_STAGE(PG8_SB(1, 1), cB + hstep + kstep, voffB);
    PG8_WAIT_V(6); PG8_BAR;
    for (;;) {
        const bool has_next = S.next(ui + 1, nxt);
        const char* nA = has_next ? (const char*)g.A + (size_t)nxt.pm * tstep + (size_t)nxt.k0 * kstep : cA; const char* nB = has_next ? (const char*)g.Bt + (size_t)nxt.pn * tstep + (size_t)nxt.k0 * kstep : cB;
        const int nt = cur.nt;
        for (int t = 0; t < nt; t += 2) {
            const bool last = (t == nt - 2);
            const char* a1 = cA + (size_t)(t + 1) * kstep;
            const char* a2 = last ? nA : cA + (size_t)(t + 2) * kstep; const char* b2 = last ? nB : cB + (size_t)(t + 2) * kstep;
            const char* a3 = a2 + kstep; const char* b3 = b2 + kstep;
            PG8_LDB(B0, 0, 0); PG8_LDB(B1, 0, 1); PG8_SCHED; PG8_LDA(At, 0, 0); PG8_STAGE(PG8_SA(1, 1), a1 + hstep, voffA);
            PG8_WAIT_V(8); PG8_WAIT_L(0); PG8_BAR; PG8_MMA(0, 0, At, B0); PG8_MMA(0, 1, At, B1); PG8_BAR; PG8_SCHED;
            PG8_LDA(At, 0, 1); PG8_STAGE(PG8_SB(0, 0), b2, voffB); PG8_STAGE(PG8_SB(0, 1), b2 + hstep, voffB); PG8_STAGE(PG8_SA(0, 0), a2, voffA);
            PG8_WAIT_V(8); PG8_WAIT_L(0); PG8_BAR; PG8_MMA(1, 0, At, B0); PG8_MMA(1, 1, At, B1); PG8_BAR; PG8_SCHED;
            PG8_LDB(B0, 1, 0); PG8_LDB(B1, 1, 1); PG8_SCHED; PG8_LDA(At, 1, 0); PG8_STAGE(PG8_SA(0, 1), a2 + hstep, voffA);
            PG8_WAIT_V(8); PG8_WAIT_L(0); PG8_BAR; PG8_MMA(0, 0, At, B0); PG8_MMA(0, 1, At, B1); PG8_BAR; PG8_SCHED;
            PG8_LDA(At, 1, 1); PG8_STAGE(PG8_SB(1, 0), b3, voffB); PG8_STAGE(PG8_SB(1, 1), b3 + hstep, voffB); PG8_STAGE(PG8_SA(1, 0), a3, voffA);
            PG8_WAIT_V(8); PG8_WAIT_L(0); PG8_BAR; PG8_MMA(1, 0, At, B0); PG8_MMA(1, 1, At, B1); PG8_BAR; PG8_SCHED;
        }
        if (wr == 0) PG8_BAR;
        E(acc, cur, wr, wc, fr, fq);
        if (!has_next) break;
        if (!cur.keep) {
#pragma unroll
            for (int a = 0; a < 2; ++a)
#pragma unroll
                for (int b = 0; b < 2; ++b)
#pragma unroll
                    for (int m = 0; m < 4; ++m)
#pragma unroll
                        for (int n = 0; n < 2; ++n) acc[a][b][m][n] = (f32x4){0.f, 0.f, 0.f, 0.f};
        }
        cur = nxt; cA = nA; cB = nB; ++ui;
        if (wr == 1) PG8_BAR;
    }
    PG8_WAIT_V(0);
    PG8_BAR;
#undef PG8_SA
#undef PG8_SB
#undef PG8_STAGE
#undef PG8_LDA
#undef PG8_LDB
#undef PG8_MMA
#undef PG8_WAIT_V
#undef PG8_WAIT_L
#undef PG8_BAR
#undef PG8_SCHED
}

struct TailOrder {
    int i, G, NT;
    __device__ __forceinline__ bool next(int k, Unit& u) const {
        if (G != 256) { const int t = i + k * G; if (t >= 288) return false; u.pm = t >> 3; u.pn = t & 7; u.k0 = 0; u.nt = NT; u.mode = MODE_OUT; u.aux = 0; u.keep = 0; return true; }
        if (k == 0) { const int tt = i >> 3, s = i & 7; u.pm = 32 + (tt >> 3); u.pn = tt & 7; u.k0 = s * (NT >> 3); u.nt = NT >> 3; u.mode = MODE_SLAB; u.aux = i; u.keep = 0; return true; }
        if (k == 1) { u.pm = i >> 3; u.pn = i & 7; u.k0 = 0; u.nt = NT; u.mode = MODE_OUT; u.aux = 0; u.keep = 0; return true; }
        return false;
    }
};
struct MixOrder {
    int i, G;
    __device__ __forceinline__ static int seg_lo(int s) { return s == 0 ? 0 : (s == 1 ? 32 : 96); }
    __device__ __forceinline__ static int seg_hi(int s) { return s == 0 ? 32 : (s == 1 ? 96 : 104); }
    __device__ __forceinline__ bool next(int k, Unit& u) const {
        int c = 0;
        if (G == 256) {
            const int tt = i >> 3, s = i & 7, ka = 2 * ((52 * s) >> 3), kb = 2 * ((52 * (s + 1)) >> 3);
#pragma unroll
            for (int sg = 0; sg < 3; ++sg) { const int lo = ka > seg_lo(sg) ? ka : seg_lo(sg), hi = kb < seg_hi(sg) ? kb : seg_hi(sg);
                if (hi > lo) { if (c == k) { const bool lastp = kb <= seg_hi(sg); u.pm = 32 + (tt >> 3); u.pn = tt & 7; u.k0 = lo; u.nt = hi - lo; u.mode = lastp ? MODE_SLAB : MODE_MID; u.aux = (sg << 16) | i; u.keep = lastp ? 0 : 1; return true; } ++c; } }
#pragma unroll
            for (int sg = 0; sg < 3; ++sg) { if (c == k) { u.pm = i >> 3; u.pn = i & 7; u.k0 = seg_lo(sg); u.nt = seg_hi(sg) - seg_lo(sg); u.mode = sg == 2 ? MODE_OUT : MODE_MID; u.aux = sg << 16; u.keep = sg == 2 ? 0 : 1; return true; } ++c; }
            return false;
        }
        const int t = i + (k / 3) * G, sg = k % 3; if (t >= 288) return false;
        u.pm = t >> 3; u.pn = t & 7; u.k0 = seg_lo(sg); u.nt = seg_hi(sg) - seg_lo(sg); u.mode = sg == 2 ? MODE_OUT : MODE_MID; u.aux = sg << 16; u.keep = sg == 2 ? 0 : 1; return true;
    }
};
}

constexpr int NWAVES = 8;
#ifndef MK_PER_PHASE
#define MK_PER_PHASE 0
#endif
constexpr int N_PHASES = 11;
#ifndef REP_MASK
#define REP_MASK 0
#endif

constexpr size_t MiB = 1u << 20;
constexpr size_t WS_CTL = 0, CTL_ZERO_BYTES = 1 * MiB;
constexpr size_t WS_WIN = 2 * MiB;
constexpr size_t WS_WCAT = 94 * MiB;
constexpr size_t WS_WO = 120 * MiB, WS_W1 = 128 * MiB, WS_W2 = 160 * MiB, WS_WKV = 192 * MiB;
constexpr size_t WS_XN = 196 * MiB;
constexpr size_t WS_MEMN = 232 * MiB, WS_KVB = 236 * MiB, WS_DT = 238 * MiB;
constexpr size_t WS_PROJ = 241 * MiB;
constexpr size_t WS_XC = 646 * MiB;
constexpr size_t WS_ACT = 754 * MiB;
constexpr int LDACT = 6656, ACT_UA = 0, ACT_YS = 2048, ACT_OA = 6144;
constexpr size_t WS_MX = 871 * MiB;
constexpr size_t WS_SLAB = 943 * MiB;
constexpr size_t WS_END = 1007 * MiB;
constexpr int CW_TMO = 0, CW_CODE = 1, CW_BAR = 4096, CW_CNT = 8192;

constexpr int RING_OFF = 0, RING_BYTES = 151552;
constexpr int LDSCTL_OFF = RING_BYTES, MISC_OFF = LDSCTL_OFF + 320;
constexpr int LDS_BYTES = 152576;
static_assert(MISC_OFF + 128 <= LDS_BYTES, "LDS map");

#define GAS __attribute__((address_space(1)))
#define LAS __attribute__((address_space(3)))
typedef unsigned short bf16;
typedef unsigned v4u __attribute__((ext_vector_type(4)));
typedef unsigned v2u __attribute__((ext_vector_type(2)));
typedef float f32x4 __attribute__((ext_vector_type(4)));
typedef short bf16x8 __attribute__((ext_vector_type(8)));
typedef GAS unsigned gu32;
typedef GAS unsigned long long gu64;
#define RLX_AGENT __ATOMIC_RELAXED, __HIP_MEMORY_SCOPE_AGENT
#define LDS_WAIT() asm volatile("s_waitcnt lgkmcnt(0)" ::: "memory")
#define VM_WAIT() asm volatile("s_waitcnt vmcnt(0)" ::: "memory")
__device__ __forceinline__ unsigned f2bf(float f) { unsigned u = __builtin_bit_cast(unsigned, f); return (u + 0x7fffu + ((u >> 16) & 1u)) >> 16; }
__device__ __forceinline__ unsigned pk2(float lo, float hi) { return f2bf(lo) | (f2bf(hi) << 16); }
__device__ __forceinline__ float bflo(unsigned w) { return __uint_as_float(w << 16); }
__device__ __forceinline__ float bfhi(unsigned w) { return __uint_as_float(w & 0xffff0000u); }
__device__ __forceinline__ void unpack8(const v4u w, float* f) { f[0] = bflo(w.x); f[1] = bfhi(w.x); f[2] = bflo(w.y); f[3] = bfhi(w.y); f[4] = bflo(w.z); f[5] = bfhi(w.z); f[6] = bflo(w.w); f[7] = bfhi(w.w); }
__device__ __forceinline__ v4u pack8(const float* f) { v4u w; w.x = pk2(f[0], f[1]); w.y = pk2(f[2], f[3]); w.z = pk2(f[4], f[5]); w.w = pk2(f[6], f[7]); return w; }
__device__ __forceinline__ float wave_sum(float v) {
#pragma unroll
    for (int o = 1; o < 64; o <<= 1) v += __shfl_xor(v, o);
    return v;
}

#define XB_TMO      128
#define XB_XCNT(j)  (256  + 64 * (j))
#define XB_XSUB(j)  (1280 + 64 * (j))
#define XB_XGEN(j)  (2304 + 64 * (j))
#define XB_TOP      3328
#define XB_TOPGEN   3392
#define XCD_BAR_WORDS 3456
#define XB_SPIN_CAP (1u << 18)
__device__ __forceinline__ unsigned xb_ld(unsigned* p)              { return __hip_atomic_load(p, __ATOMIC_RELAXED, __HIP_MEMORY_SCOPE_AGENT); }
__device__ __forceinline__ unsigned xb_add(unsigned* p, unsigned v) { return __hip_atomic_fetch_add(p, v, __ATOMIC_RELAXED, __HIP_MEMORY_SCOPE_AGENT); }
__device__ __forceinline__ unsigned xb_xcc_id() { return (unsigned)__builtin_amdgcn_s_getreg((3 << 11) | 20) & 0xFu; }
#define XB_SPIN(cond, bar) do { unsigned _sp = 0; while (cond) { __builtin_amdgcn_s_sleep(1); \
    if ((++_sp & 255u) == 0u) { if (xb_ld(&(bar)[XB_TMO])) break; if (_sp > XB_SPIN_CAP) { atomicAdd(&(bar)[XB_TMO], 1u); break; } } } } while (0)
struct XcdBarrier { unsigned* bar; unsigned x; volatile LAS unsigned* st; };
__device__ __forceinline__ XcdBarrier xcd_barrier_post(unsigned* bar, volatile LAS unsigned* st) {
    XcdBarrier b; b.bar = bar; b.x = xb_xcc_id(); b.st = st;
    if (threadIdx.x == 0) (void)xb_add(&bar[XB_XCNT(b.x)], 1u);
    return b;
}
__device__ __forceinline__ void xcd_barrier_complete(unsigned* bar, unsigned x, unsigned& nloc, unsigned& nx) {
    const unsigned G = gridDim.x * gridDim.y * gridDim.z;
    unsigned sum, cnt, mine, sp = 0u;
    for (;;) {
        sum = 0u; cnt = 0u; mine = 0u;
#pragma unroll
        for (unsigned j = 0; j < 16; ++j) { const unsigned c = xb_ld(&bar[XB_XCNT(j)]); sum += c; cnt += (c > 0u) ? 1u : 0u; mine = (j == x) ? c : mine; }
        if (sum == G) break;
        __builtin_amdgcn_s_sleep(1);
        if ((++sp & 255u) == 0u) { if (xb_ld(&bar[XB_TMO])) break; if (sp > XB_SPIN_CAP) { atomicAdd(&bar[XB_TMO], 1u); break; } }
    }
    nloc = mine > 0u ? mine : 1u; nx = cnt > 0u ? cnt : 1u;
}
__device__ __forceinline__ void xcd_barrier(const XcdBarrier& b) {
    asm volatile("s_waitcnt vmcnt(0)" ::: "memory");
    __syncthreads();
    if (threadIdx.x == 0) {
        unsigned* bar = b.bar;
        __builtin_amdgcn_s_waitcnt(0);
        unsigned nloc = b.st[0], nx = b.st[1];
        if (nloc == 0u) { xcd_barrier_complete(bar, b.x, nloc, nx); b.st[0] = nloc; b.st[1] = nx; }
        const unsigned old = xb_add(&bar[XB_XSUB(b.x)], 1u);
        const unsigned gen = old / nloc;
        if (old + 1u == (gen + 1u) * nloc) {
            __builtin_amdgcn_fence(__ATOMIC_RELEASE, "agent");
            asm volatile("s_waitcnt vmcnt(0)" ::: "memory");
            const unsigned og = xb_add(&bar[XB_TOP], 1u);
            const unsigned tg = og / nx;
            if (og + 1u == (tg + 1u) * nx) xb_add(&bar[XB_TOPGEN], 1u);
            else XB_SPIN(xb_ld(&bar[XB_TOPGEN]) == tg, bar);
            __builtin_amdgcn_fence(__ATOMIC_ACQUIRE, "agent");
            xb_add(&bar[XB_XGEN(b.x)], 1u);
            asm volatile("s_waitcnt vmcnt(0)" ::: "memory");
        } else {
            XB_SPIN(xb_ld(&bar[XB_XGEN(b.x)]) == gen, bar);
            __builtin_amdgcn_fence(__ATOMIC_ACQUIRE, "agent");
            asm volatile("s_waitcnt vmcnt(0)" ::: "memory");
        }
    }
    __syncthreads();
}

struct Args { const float* in[28]; float* out; unsigned char* ws; int ph_lo, ph_hi; };
enum { I_XP = 0, I_XS, I_MEM, I_CK, I_CV, I_SCA, I_SCB, I_SSM, I_NPRE, I_NPOST, I_NMPRE, I_NMPOST, I_NMEM, I_WIN, I_CAW, I_WOA, I_CBW, I_CBB, I_DTB, I_ALOG, I_DSK, I_SNW, I_WOB, I_WKV, I_WOX, I_WO, I_WF1, I_WF2 };

struct Frame {
    LAS unsigned char* lds;
    int tid, lane, wave, vcu, G;
};

__device__ __forceinline__ void p0_transpose_item(const float* W, int N, bf16* WT, int ldw, int koff, int k0, int n0, int drow, LAS float* scr, int lane) {
#pragma unroll 8
    for (int i = 0; i < 32; ++i) { const int kk = 2 * i + (lane >> 5); scr[kk * 33 + (lane & 31)] = W[(size_t)(k0 + kk) * N + n0 + (lane & 31)]; }
    LDS_WAIT(); asm volatile("" ::: "memory");
    const int c = lane & 7;
#pragma unroll
    for (int j = 0; j < 4; ++j) { const int n = (lane >> 3) + 8 * j; const LAS float* s = scr + (8 * c) * 33 + n;
        v4u o; o.x = pk2(s[0 * 33], s[1 * 33]); o.y = pk2(s[2 * 33], s[3 * 33]); o.z = pk2(s[4 * 33], s[5 * 33]); o.w = pk2(s[6 * 33], s[7 * 33]);
        *(GAS v4u*)(WT + (size_t)(drow + n) * ldw + koff + k0 + 8 * c) = o; }
    LDS_WAIT(); asm volatile("" ::: "memory");
}
__device__ __forceinline__ int win_dest_row(int n0) {
    if (n0 < 16384) return n0;
    if (n0 < 16448) return C_DT + (n0 - 16384);
    if (n0 < 16960) return C_Q + (n0 - 16448);
    return C_G + (n0 - 16960);
}
__device__ __forceinline__ void rms_row_to_bf16(const float* xrow, const float* g, bf16* orow, int lane) {
    const GAS f32x4* xr = (const GAS f32x4*)xrow + lane;
    f32x4 v[8]; float s = 0.f;
#pragma unroll
    for (int j = 0; j < 8; ++j) { v[j] = xr[64 * j]; s += (v[j].x * v[j].x + v[j].y * v[j].y) + (v[j].z * v[j].z + v[j].w * v[j].w); }
    const float rs = 1.0f / sqrtf(wave_sum(s) * (1.f / DM) + EPS);
    const GAS f32x4* gr = (const GAS f32x4*)g + lane;
    GAS v2u* o8 = (GAS v2u*)orow + lane;
#pragma unroll
    for (int j = 0; j < 8; ++j) { const f32x4 gg = gr[64 * j]; v2u w; w.x = pk2(v[j].x * rs * gg.x, v[j].y * rs * gg.y); w.y = pk2(v[j].z * rs * gg.z, v[j].w * rs * gg.w); o8[64 * j] = w; }
}
__device__ __forceinline__ void phase_prologue(const Frame& F, const Args& a) {
    unsigned char* ws = a.ws;
    LAS float* scr = (LAS float*)(F.lds + RING_OFF + F.wave * 16384);
    const int gw = F.vcu * NWAVES + F.wave, NGW = F.G * NWAVES;
    constexpr int I_0 = 32 * 722, I_1 = I_0 + 32 * 64, I_2 = I_1 + 64 * 64, I_3 = I_2 + 8 * 64, I_4 = I_3 + 32 * 64, I_5 = I_4 + 32 * 256, I_6 = I_5 + 128 * 64, I_7 = I_6 + 32 * 32;
    for (int it = gw; it < I_7; it += NGW) {
        const float* W; int N, r, ldw, koff = 0; bf16* WT; bool win = false;
        if (it < I_0) { W = a.in[I_WIN]; ldw = 2048; N = 23104; r = it; WT = (bf16*)(ws + WS_WIN); win = true; }
        else if (it < I_1) { W = a.in[I_WOA]; ldw = LDACT; N = 2048; r = it - I_0; WT = (bf16*)(ws + WS_WCAT); koff = ACT_UA; }
        else if (it < I_2) { W = a.in[I_WOB]; ldw = LDACT; N = 2048; r = it - I_1; WT = (bf16*)(ws + WS_WCAT); koff = ACT_YS; }
        else if (it < I_3) { W = a.in[I_WOX]; ldw = LDACT; N = 2048; r = it - I_2; WT = (bf16*)(ws + WS_WCAT); koff = ACT_OA; }
        else if (it < I_4) { W = a.in[I_WO]; ldw = 2048; N = 2048; r = it - I_3; WT = (bf16*)(ws + WS_WO); }
        else if (it < I_5) { W = a.in[I_WF1]; ldw = 2048; N = 8192; r = it - I_4; WT = (bf16*)(ws + WS_W1); }
        else if (it < I_6) { W = a.in[I_WF2]; ldw = 8192; N = 2048; r = it - I_5; WT = (bf16*)(ws + WS_W2); }
        else { W = a.in[I_WKV]; ldw = 2048; N = 1024; r = it - I_6; WT = (bf16*)(ws + WS_WKV); }
        const int nblk = N / 32, kb = r / nblk, nb = r % nblk, n0 = 32 * nb;
        p0_transpose_item(W, N, WT, ldw, koff, 64 * kb, n0, win ? win_dest_row(n0) : n0, scr, F.lane);
    }
    { GAS v4u* z = (GAS v4u*)(ws + WS_WIN + (size_t)23104 * 2048 * 2); const int n16 = 192 * 2048 * 2 / 16;
      for (int i = F.vcu * 512 + F.tid; i < n16; i += F.G * 512) z[i] = (v4u){0u, 0u, 0u, 0u}; }
    for (int m = gw; m < NTOK + NMEMROW; m += NGW) {
        if (m < NTOK) { const float* xr = m < NTOK_P ? a.in[I_XP] + (size_t)m * DM : a.in[I_XS] + (size_t)(m - NTOK_P) * DM;
            rms_row_to_bf16(xr, a.in[I_NPRE], (bf16*)(ws + WS_XN) + (size_t)m * DM, F.lane); }
        else { const int mm = m - NTOK; rms_row_to_bf16(a.in[I_MEM] + (size_t)mm * DM, a.in[I_NMEM], (bf16*)(ws + WS_MEMN) + (size_t)mm * DM, F.lane); }
    }
}

__device__ __forceinline__ void ld8f(const float* p, float* f) { const f32x4 a = *(const GAS f32x4*)p, b = *(const GAS f32x4*)(p + 4); f[0] = a.x; f[1] = a.y; f[2] = a.z; f[3] = a.w; f[4] = b.x; f[5] = b.y; f[6] = b.z; f[7] = b.w; }
__device__ __forceinline__ void st8f(float* p, const float* f) { *(GAS f32x4*)p = (f32x4){f[0], f[1], f[2], f[3]}; *(GAS f32x4*)(p + 4) = (f32x4){f[4], f[5], f[6], f[7]}; }
__device__ __forceinline__ void ld8bf(const bf16* p, float* f) { unpack8(*(const GAS v4u*)p, f); }
__device__ __forceinline__ void phase_conv(const Frame& F, const Args& a) {
    unsigned char* ws = a.ws;
    const bf16* P = (const bf16*)(ws + WS_PROJ); bf16* UA = (bf16*)(ws + WS_ACT) + ACT_UA; bf16* XC = (bf16*)(ws + WS_XC);
    const long total = (long)NTOK * 1024;
    for (long idx = (long)F.vcu * 512 + F.tid; idx < total; idx += (long)F.G * 512) {
        const int row = (int)(idx >> 10), c = (int)(idx & 1023);
        int b, t, L; bool smp;
        if (row < NTOK_P) { b = row >> 11; t = row & 2047; L = SEQ_P; smp = false; } else { const int r2 = row - NTOK_P; b = r2 >> 3; t = r2 & 7; L = SEQ_S; smp = true; }
        if (c < 256) {
            const int ch = c * 8; float acc[8], vcur[8];
#pragma unroll
            for (int i = 0; i < 8; ++i) acc[i] = 0.f;
#pragma unroll
            for (int k = 0; k < 3; ++k) {
                float w[8], v[8]; ld8f(a.in[I_CAW] + k * 2048 + ch, w);
                const int ui = t + k;
                if (ui >= 2) { float ca[8], ha[8]; const bf16* pr = P + (size_t)(row + k - 2) * NPROJ; ld8bf(pr + C_CA + ch, ca); ld8bf(pr + C_HA + ch, ha);
#pragma unroll
                    for (int i = 0; i < 8; ++i) v[i] = ca[i] * ha[i]; }
                else if (smp) ld8f(a.in[I_SCA] + ((size_t)b * 2 + ui) * 2048 + ch, v);
                else {
#pragma unroll
                    for (int i = 0; i < 8; ++i) v[i] = 0.f; }
#pragma unroll
                for (int i = 0; i < 8; ++i) { acc[i] += w[i] * v[i]; if (k == 2) vcur[i] = v[i]; }
            }
            float ba[8], o[8]; ld8bf(P + (size_t)row * NPROJ + C_BA + ch, ba);
#pragma unroll
            for (int i = 0; i < 8; ++i) o[i] = ba[i] * acc[i];
            *(GAS v4u*)(UA + (size_t)row * LDACT + ch) = pack8(o);
            if (t >= L - 2) { const int j = t - (L - 2); st8f(a.out + (smp ? O_CAS : O_CAP) + ((size_t)b * 2 + j) * 2048 + ch, vcur); }
        } else {
            const int ch = (c - 256) * 8; float acc[8], xcur[8];
            ld8f(a.in[I_CBB] + ch, acc);
#pragma unroll
            for (int k = 0; k < 4; ++k) {
                float w[8], v[8]; ld8f(a.in[I_CBW] + k * 6144 + ch, w);
                const int ui = t + k;
                if (ui >= 3) ld8bf(P + (size_t)(row + k - 3) * NPROJ + C_XBC + ch, v);
                else if (smp) ld8f(a.in[I_SCB] + ((size_t)b * 3 + ui) * 6144 + ch, v);
                else {
#pragma unroll
                    for (int i = 0; i < 8; ++i) v[i] = 0.f; }
#pragma unroll
                for (int i = 0; i < 8; ++i) { acc[i] += w[i] * v[i]; if (k == 3) xcur[i] = v[i]; }
            }
            float o[8];
#pragma unroll
            for (int i = 0; i < 8; ++i) o[i] = acc[i] * __builtin_amdgcn_rcpf(1.0f + __expf(-acc[i]));
            *(GAS v4u*)(XC + (size_t)row * 6144 + ch) = pack8(o);
            if (t >= L - 3) { const int j = t - (L - 3); st8f(a.out + (smp ? O_CBS : O_CBP) + ((size_t)b * 3 + j) * 6144 + ch, xcur); }
        }
    }
}

template <bool SMP> __device__ __forceinline__ void ssd_seq_unit(const Frame& F, const Args& a, int b, int hd) {
    unsigned char* ws = a.ws;
    constexpr int L = SMP ? SEQ_S : SEQ_P, TB = SMP ? 8 : 64;
    const bf16* XC = (const bf16*)(ws + WS_XC); const float* DT = (const float*)(ws + WS_DT); bf16* YS = (bf16*)(ws + WS_ACT) + ACT_YS;
    LAS float* Bs = (LAS float*)(F.lds + RING_OFF); LAS float* Cs = Bs + 64 * 128; LAS float* xs = Cs + 64 * 128; LAS float* ys = xs + 64 * 64; LAS float* dts = ys + 64 * 64;
    const int tid = F.tid, p = tid >> 3, ng = tid & 7, g = hd >> 3;
    const int row0 = SMP ? NTOK_P + b * SEQ_S : b * SEQ_P;
    const float A = -__expf(a.in[I_ALOG][hd]), Dk = a.in[I_DSK][hd];
    float h[16];
    if (SMP) { const float* hp = a.in[I_SSM] + (((size_t)b * NHEAD + hd) * HDIM + p) * DSTATE + ng * 16;
#pragma unroll
        for (int i = 0; i < 4; ++i) { const f32x4 v = *(const GAS f32x4*)(hp + 4 * i); h[4 * i] = v.x; h[4 * i + 1] = v.y; h[4 * i + 2] = v.z; h[4 * i + 3] = v.w; } }
    else {
#pragma unroll
        for (int i = 0; i < 16; ++i) h[i] = 0.f; }
    for (int t0 = 0; t0 < L; t0 += TB) {
        __syncthreads();
        for (int id = tid; id < TB * 16; id += 512) { const int r = id >> 4, cc = id & 15; const bf16* pr = XC + (size_t)(row0 + t0 + r) * 6144;
            float f[8]; ld8bf(pr + 4096 + g * 128 + cc * 8, f);
#pragma unroll
            for (int i = 0; i < 8; ++i) Bs[r * 128 + cc * 8 + i] = f[i];
            ld8bf(pr + 5120 + g * 128 + cc * 8, f);
#pragma unroll
            for (int i = 0; i < 8; ++i) Cs[r * 128 + cc * 8 + i] = f[i]; }
        for (int id = tid; id < TB * 8; id += 512) { const int r = id >> 3, cc = id & 7; float f[8]; ld8bf(XC + (size_t)(row0 + t0 + r) * 6144 + hd * 64 + cc * 8, f);
#pragma unroll
            for (int i = 0; i < 8; ++i) xs[r * 64 + cc * 8 + i] = f[i]; }
        if (tid < TB) dts[tid] = DT[(size_t)(row0 + t0 + tid) * 64 + hd];
        __syncthreads();
        for (int t = 0; t < TB; ++t) {
            const float dt = dts[t], dA = __expf(dt * A), xv = xs[t * 64 + p], dtx = dt * xv;
            float y = 0.f;
#pragma unroll
            for (int i = 0; i < 4; ++i) { const f32x4 bv = *(const LAS f32x4*)(Bs + t * 128 + ng * 16 + 4 * i), cv = *(const LAS f32x4*)(Cs + t * 128 + ng * 16 + 4 * i);
                h[4 * i] = h[4 * i] * dA + dtx * bv.x; h[4 * i + 1] = h[4 * i + 1] * dA + dtx * bv.y; h[4 * i + 2] = h[4 * i + 2] * dA + dtx * bv.z; h[4 * i + 3] = h[4 * i + 3] * dA + dtx * bv.w;
                y += h[4 * i] * cv.x + h[4 * i + 1] * cv.y + h[4 * i + 2] * cv.z + h[4 * i + 3] * cv.w; }
            y += __shfl_xor(y, 1); y += __shfl_xor(y, 2); y += __shfl_xor(y, 4);
            if (ng == 0) ys[t * 64 + p] = y + Dk * xv;
        }
        __syncthreads();
        for (int id = tid; id < TB * 8; id += 512) { const int r = id >> 3, cc = id & 7; float f[8];
#pragma unroll
            for (int i = 0; i < 8; ++i) f[i] = ys[r * 64 + cc * 8 + i];
            *(GAS v4u*)(YS + (size_t)(row0 + t0 + r) * LDACT + hd * 64 + cc * 8) = pack8(f); }
    }
    { float* hp = a.out + (SMP ? O_SSS : O_SSP) + (((size_t)b * NHEAD + hd) * HDIM + p) * DSTATE + ng * 16;
#pragma unroll
      for (int i = 0; i < 4; ++i) *(GAS f32x4*)(hp + 4 * i) = (f32x4){h[4 * i], h[4 * i + 1], h[4 * i + 2], h[4 * i + 3]}; }
}

constexpr int KS_STRIDE = 272, VT_STRIDE = 528;
template <bool SMP> __device__ __forceinline__ void attn_unit(const Frame& F, const Args& a, int b, int hh, int qb) {
    unsigned char* ws = a.ws;
    const bf16* P = (const bf16*)(ws + WS_PROJ); bf16* OA = (bf16*)(ws + WS_ACT) + ACT_OA;
    LAS unsigned char* Ks = F.lds + RING_OFF; LAS unsigned char* Vt = Ks + 256 * KS_STRIDE;
    const int tid = F.tid, lane = F.lane, wid = F.wave;
    __syncthreads();
    for (int id = tid; id < 256 * 16; id += 512) { const int key = id >> 4, cc = id & 15; float kf[8], vf[8]; v4u kw;
        if (SMP) { const size_t off = (((size_t)b * 256 + key) * 4 + hh) * 128 + cc * 8; ld8f(a.in[I_CK] + off, kf); ld8f(a.in[I_CV] + off, vf); kw = pack8(kf); }
        else { const bf16* kv = (const bf16*)(ws + WS_KVB) + ((size_t)b * 256 + key) * 1024 + hh * 128 + cc * 8; kw = *(const GAS v4u*)kv; ld8bf(kv + 512, vf); }
        *(LAS v4u*)(Ks + key * KS_STRIDE + cc * 16) = kw;
#pragma unroll
        for (int i = 0; i < 8; ++i) *(LAS unsigned short*)(Vt + (cc * 8 + i) * VT_STRIDE + key * 2) = (unsigned short)f2bf(vf[i]); }
    __syncthreads();
    if (SMP && wid != 0) return;
    const int fr = lane & 15, g = lane >> 4;
    const int qrow0 = SMP ? NTOK_P + b * SEQ_S : b * SEQ_P + qb * 128 + wid * 16;
    const int qr = SMP ? (fr & 7) : fr;
    bf16x8 qf[4];
#pragma unroll
    for (int ks = 0; ks < 4; ++ks) qf[ks] = *(const GAS bf16x8*)(P + (size_t)(qrow0 + qr) * NPROJ + C_Q + hh * 128 + ks * 32 + g * 8);
    f32x4 s[16];
#pragma unroll
    for (int blk = 0; blk < 16; ++blk) { s[blk] = (f32x4){0.f, 0.f, 0.f, 0.f};
#pragma unroll
        for (int ks = 0; ks < 4; ++ks) { const bf16x8 kf = *(const LAS bf16x8*)(Ks + (blk * 16 + fr) * KS_STRIDE + ks * 64 + g * 16);
            s[blk] = __builtin_amdgcn_mfma_f32_16x16x32_bf16(kf, qf[ks], s[blk], 0, 0, 0); } }
    const float sc = 0.08838834764831845f;
    float mx = -3.0e38f;
#pragma unroll
    for (int blk = 0; blk < 16; ++blk)
#pragma unroll
        for (int r = 0; r < 4; ++r) { s[blk][r] *= sc; mx = fmaxf(mx, s[blk][r]); }
    mx = fmaxf(mx, __shfl_xor(mx, 16)); mx = fmaxf(mx, __shfl_xor(mx, 32));
    float sum = 0.f;
#pragma unroll
    for (int blk = 0; blk < 16; ++blk)
#pragma unroll
        for (int r = 0; r < 4; ++r) { s[blk][r] = __expf(s[blk][r] - mx); sum += s[blk][r]; }
    sum += __shfl_xor(sum, 16); sum += __shfl_xor(sum, 32);
    const float inv = 1.0f / sum;
    bf16x8 pf[8];
#pragma unroll
    for (int k2 = 0; k2 < 8; ++k2) { v4u w; w.x = pk2(s[2 * k2][0] * inv, s[2 * k2][1] * inv); w.y = pk2(s[2 * k2][2] * inv, s[2 * k2][3] * inv);
        w.z = pk2(s[2 * k2 + 1][0] * inv, s[2 * k2 + 1][1] * inv); w.w = pk2(s[2 * k2 + 1][2] * inv, s[2 * k2 + 1][3] * inv); pf[k2] = __builtin_bit_cast(bf16x8, w); }
#pragma unroll
    for (int db = 0; db < 8; ++db) { f32x4 o = (f32x4){0.f, 0.f, 0.f, 0.f};
#pragma unroll
        for (int k2 = 0; k2 < 8; ++k2) { const LAS unsigned char* vp = Vt + (db * 16 + fr) * VT_STRIDE + (k2 * 32 + 4 * g) * 2;
            const v2u lo = *(const LAS v2u*)vp, hi = *(const LAS v2u*)(vp + 32);
            const v4u vw = (v4u){lo.x, lo.y, hi.x, hi.y};
            o = __builtin_amdgcn_mfma_f32_16x16x32_bf16(__builtin_bit_cast(bf16x8, vw), pf[k2], o, 0, 0, 0); }
        if (!SMP || fr < 8) { v2u w; w.x = pk2(o[0], o[1]); w.y = pk2(o[2], o[3]); *(GAS v2u*)(OA + (size_t)(qrow0 + fr) * LDACT + hh * 128 + db * 16 + 4 * g) = w; } }
}

__device__ __forceinline__ void phase_gnorm(const Frame& F, const Args& a) {
    unsigned char* ws = a.ws;
    const bf16* P = (const bf16*)(ws + WS_PROJ); bf16* YS = (bf16*)(ws + WS_ACT) + ACT_YS;
    const int gw = F.vcu * NWAVES + F.wave, NGW = F.G * NWAVES;
    for (int it = gw; it < NTOK * NGRP; it += NGW) { const int row = it >> 3, g = it & 7, col = g * 512 + F.lane * 8;
        float y[8], z[8], w[8]; ld8bf(YS + (size_t)row * LDACT + col, y); ld8bf(P + (size_t)row * NPROJ + C_Z + col, z); ld8f(a.in[I_SNW] + col, w);
        float ss = 0.f;
#pragma unroll
        for (int i = 0; i < 8; ++i) { y[i] = y[i] * z[i] * __builtin_amdgcn_rcpf(1.0f + __expf(-z[i])); ss += y[i] * y[i]; }
        const float rs = 1.0f / sqrtf(wave_sum(ss) * (1.f / 512.f) + EPS);
#pragma unroll
        for (int i = 0; i < 8; ++i) y[i] = y[i] * rs * w[i];
        *(GAS v4u*)(YS + (size_t)row * LDACT + col) = pack8(y); }
}

__device__ __forceinline__ void phase_res1(const Frame& F, const Args& a) {
    unsigned char* ws = a.ws;
    const float* MX = (const float*)(ws + WS_MX); bf16* HN = (bf16*)(ws + WS_XN);
    const int gw = F.vcu * NWAVES + F.wave, NGW = F.G * NWAVES;
    for (int m = gw; m < NTOK; m += NGW) {
        const float* xr = m < NTOK_P ? a.in[I_XP] + (size_t)m * DM : a.in[I_XS] + (size_t)(m - NTOK_P) * DM;
        const GAS f32x4* mr = (const GAS f32x4*)(MX + (size_t)m * DM) + F.lane; const GAS f32x4* xv = (const GAS f32x4*)xr + F.lane;
        const GAS f32x4* g1 = (const GAS f32x4*)a.in[I_NPOST] + F.lane; const GAS f32x4* g2 = (const GAS f32x4*)a.in[I_NMPRE] + F.lane;
        f32x4 v[8]; float s = 0.f;
#pragma unroll
        for (int j = 0; j < 8; ++j) { v[j] = mr[64 * j]; s += (v[j].x * v[j].x + v[j].y * v[j].y) + (v[j].z * v[j].z + v[j].w * v[j].w); }
        const float rs = 1.0f / sqrtf(wave_sum(s) * (1.f / DM) + EPS);
        float s2 = 0.f;
        GAS f32x4* o = (GAS f32x4*)(a.out + O_Y + (size_t)m * DM) + F.lane;
#pragma unroll
        for (int j = 0; j < 8; ++j) { v[j] = xv[64 * j] + v[j] * rs * g1[64 * j]; o[64 * j] = v[j]; s2 += (v[j].x * v[j].x + v[j].y * v[j].y) + (v[j].z * v[j].z + v[j].w * v[j].w); }
        const float rs2 = 1.0f / sqrtf(wave_sum(s2) * (1.f / DM) + EPS);
        GAS v2u* o8 = (GAS v2u*)(HN + (size_t)m * DM) + F.lane;
#pragma unroll
        for (int j = 0; j < 8; ++j) { const f32x4 gg = g2[64 * j]; v2u w; w.x = pk2(v[j].x * rs2 * gg.x, v[j].y * rs2 * gg.y); w.y = pk2(v[j].z * rs2 * gg.z, v[j].w * rs2 * gg.w); o8[64 * j] = w; }
    }
}
__device__ __forceinline__ void phase_res2(const Frame& F, const Args& a) {
    unsigned char* ws = a.ws;
    const float* FFB = (const float*)(ws + WS_ACT);
    const int gw = F.vcu * NWAVES + F.wave, NGW = F.G * NWAVES;
    for (int m = gw; m < NTOK; m += NGW) {
        const GAS f32x4* fr_ = (const GAS f32x4*)(FFB + (size_t)m * DM) + F.lane; const GAS f32x4* g1 = (const GAS f32x4*)a.in[I_NMPOST] + F.lane;
        GAS f32x4* o = (GAS f32x4*)(a.out + O_Y + (size_t)m * DM) + F.lane;
        f32x4 v[8]; float s = 0.f;
#pragma unroll
        for (int j = 0; j < 8; ++j) { v[j] = fr_[64 * j]; s += (v[j].x * v[j].x + v[j].y * v[j].y) + (v[j].z * v[j].z + v[j].w * v[j].w); }
        const float rs = 1.0f / sqrtf(wave_sum(s) * (1.f / DM) + EPS);
#pragma unroll
        for (int j = 0; j < 8; ++j) o[64 * j] = o[64 * j] + v[j] * rs * g1[64 * j];
    }
}

typedef float f32x16 __attribute__((ext_vector_type(16)));
typedef short v4i16_t __attribute__((ext_vector_type(4)));
constexpr int SC_C = 0, SC_B = 32768, SC_M = 65536, SC_X = 98304, SC_H = 122880, SC_F = 147456;
constexpr int XSTR = 192;
static_assert(SC_F + 4 * 512 + 64 <= RING_BYTES, "SSD LDS map");
__device__ __forceinline__ int swz(int row, int ch) { return 256 * row + 16 * (ch ^ (((row & 3) << 2) | ((row >> 2) & 3))); }
__device__ __forceinline__ bf16x8 tr2(const LAS unsigned char* p0, const LAS unsigned char* p1) {
    const v4i16_t a = __builtin_amdgcn_ds_read_tr16_b64_v4i16((LAS v4i16_t*)p0), b = __builtin_amdgcn_ds_read_tr16_b64_v4i16((LAS v4i16_t*)p1);
    return (bf16x8){a[0], a[1], a[2], a[3], b[0], b[1], b[2], b[3]};
}
__device__ __forceinline__ void ssd_chunk_unit(const Frame& F, const Args& a, int b, int hd) {
    unsigned char* ws = a.ws;
    const bf16* XC = (const bf16*)(ws + WS_XC); const float* DT = (const float*)(ws + WS_DT); bf16* YS = (bf16*)(ws + WS_ACT) + ACT_YS;
    LAS unsigned char* Cs = F.lds + RING_OFF + SC_C; LAS unsigned char* Bs = F.lds + RING_OFF + SC_B; LAS unsigned char* Ms = F.lds + RING_OFF + SC_M;
    LAS unsigned char* Xs = F.lds + RING_OFF + SC_X; LAS unsigned char* Ht = F.lds + RING_OFF + SC_H;
    LAS float* acum = (LAS float*)(F.lds + RING_OFF + SC_F); LAS float* eacum = acum + 128; LAS float* wdt = acum + 256; LAS float* dts = acum + 384; LAS float* scal = acum + 512;
    const int tid = F.tid, lane = F.lane, w = F.wave, r32 = lane & 31, hi = lane >> 5, i16 = lane & 15, blk = (lane >> 4) & 1;
    const int g = hd >> 3, row0 = b * SEQ_P;
    const float A = -__expf(a.in[I_ALOG][hd]), Dk = a.in[I_DSK][hd];
    __syncthreads();
    for (int id = tid; id < 128 * XSTR / 16; id += 512) ((LAS v4u*)Ht)[id] = (v4u){0u, 0u, 0u, 0u};
    f32x16 hacc;
#pragma unroll
    for (int i = 0; i < 16; ++i) hacc[i] = 0.f;
    v4u cr[4], br[4], xr[2]; float dtr0 = 0.f, dtr1 = 0.f;
#define SSD_LOAD(c) do { const bf16* base_ = XC + (size_t)(row0 + 128 * (c)) * 6144; \
        _Pragma("unroll") for (int k = 0; k < 4; ++k) { const int id_ = tid + 512 * k, rr = id_ >> 4, ch = id_ & 15; cr[k] = *(const GAS v4u*)(base_ + (size_t)rr * 6144 + 5120 + g * 128 + ch * 8); br[k] = *(const GAS v4u*)(base_ + (size_t)rr * 6144 + 4096 + g * 128 + ch * 8); } \
        _Pragma("unroll") for (int k = 0; k < 2; ++k) { const int id_ = tid + 512 * k, rr = id_ >> 3, ch = id_ & 7; xr[k] = *(const GAS v4u*)(base_ + (size_t)rr * 6144 + hd * 64 + ch * 8); } \
        if (w == 0) { dtr0 = DT[(size_t)(row0 + 128 * (c) + 2 * lane) * 64 + hd]; dtr1 = DT[(size_t)(row0 + 128 * (c) + 2 * lane + 1) * 64 + hd]; } } while (0)
    SSD_LOAD(0);
    const int trq = i16 >> 2, trp = i16 & 3;
    for (int c = 0; c < 16; ++c) {
#pragma unroll
        for (int k = 0; k < 4; ++k) { const int id_ = tid + 512 * k, rr = id_ >> 4, ch = id_ & 15; *(LAS v4u*)(Cs + swz(rr, ch)) = cr[k]; *(LAS v4u*)(Bs + swz(rr, ch)) = br[k]; }
#pragma unroll
        for (int k = 0; k < 2; ++k) { const int id_ = tid + 512 * k, rr = id_ >> 3, ch = id_ & 7; *(LAS v4u*)(Xs + rr * XSTR + ch * 16) = xr[k]; }
        if (w == 0) {
            const float a0 = dtr0 * A, a1 = dtr1 * A; float v = a0 + a1;
#pragma unroll
            for (int o = 1; o < 64; o <<= 1) { const float t = __shfl_up(v, o); if (lane >= o) v += t; }
            const float ac0 = v - a1, ac1 = v, last = __shfl(v, 63);
            acum[2 * lane] = ac0; acum[2 * lane + 1] = ac1; eacum[2 * lane] = __expf(ac0); eacum[2 * lane + 1] = __expf(ac1);
            wdt[2 * lane] = dtr0 * __expf(last - ac0); wdt[2 * lane + 1] = dtr1 * __expf(last - ac1); dts[2 * lane] = dtr0; dts[2 * lane + 1] = dtr1;
            if (lane == 0) scal[0] = __expf(last);
        }
        __syncthreads();
        if (c + 1 < 16) SSD_LOAD(c + 1);
        for (int bi = 0; bi < 2; ++bi) { const int idx = w + 8 * bi; if (idx >= 10) break;
            const int qi = idx < 1 ? 0 : (idx < 3 ? 1 : (idx < 6 ? 2 : 3)), si = idx - (qi * (qi + 1)) / 2;
            f32x16 gacc;
#pragma unroll
            for (int i = 0; i < 16; ++i) gacc[i] = 0.f;
#pragma unroll
            for (int ks = 0; ks < 8; ++ks) { const bf16x8 af = *(const LAS bf16x8*)(Bs + swz(32 * si + r32, 2 * ks + hi)), bf = *(const LAS bf16x8*)(Cs + swz(32 * qi + r32, 2 * ks + hi));
                gacc = __builtin_amdgcn_mfma_f32_32x32x16_bf16(af, bf, gacc, 0, 0, 0); }
            const float acq = acum[32 * qi + r32]; const bool diag = qi == si;
#pragma unroll
            for (int g4 = 0; g4 < 4; ++g4) { const int sl = 8 * g4 + 4 * hi; const f32x4 as = *(const LAS f32x4*)(acum + 32 * si + sl), ds = *(const LAS f32x4*)(dts + 32 * si + sl);
                float v[4];
#pragma unroll
                for (int j = 0; j < 4; ++j) { v[j] = gacc[4 * g4 + j] * __expf(acq - as[j]) * ds[j]; if (diag && (sl + j) > r32) v[j] = 0.f; }
                v2u pw; pw.x = pk2(v[0], v[1]); pw.y = pk2(v[2], v[3]);
                *(LAS v2u*)(Ms + swz(32 * qi + r32, 4 * si + g4) + 8 * hi) = pw; }
        }
        __syncthreads();
        { const int qi = w >> 1, pj = w & 1;
            f32x16 yacc;
#pragma unroll
            for (int i = 0; i < 16; ++i) yacc[i] = 0.f;
#pragma unroll
            for (int ks = 0; ks < 8; ++ks) { const bf16x8 af = *(const LAS bf16x8*)(Cs + swz(32 * qi + r32, 2 * ks + hi));
                const LAS unsigned char* hp = Ht + (16 * ks + 8 * hi + trq) * XSTR + (32 * pj + 16 * blk + 4 * trp) * 2;
                yacc = __builtin_amdgcn_mfma_f32_32x32x16_bf16(af, tr2(hp, hp + 4 * XSTR), yacc, 0, 0, 0); }
#pragma unroll
            for (int g4 = 0; g4 < 4; ++g4) { const f32x4 e = *(const LAS f32x4*)(eacum + 32 * qi + 8 * g4 + 4 * hi);
#pragma unroll
                for (int j = 0; j < 4; ++j) yacc[4 * g4 + j] *= e[j]; }
            for (int ks = 0; ks < 2 * (qi + 1); ++ks) { const bf16x8 af = *(const LAS bf16x8*)(Ms + swz(32 * qi + r32, 2 * ks + hi));
                const LAS unsigned char* xp = Xs + (16 * ks + 8 * hi + trq) * XSTR + (32 * pj + 16 * blk + 4 * trp) * 2;
                yacc = __builtin_amdgcn_mfma_f32_32x32x16_bf16(af, tr2(xp, xp + 4 * XSTR), yacc, 0, 0, 0); }
            const int p = 32 * pj + r32;
#pragma unroll
            for (int r = 0; r < 16; ++r) { const int q = 32 * qi + (r & 3) + 8 * (r >> 2) + 4 * hi;
                const float xv = __uint_as_float((unsigned)(*(const LAS unsigned short*)(Xs + q * XSTR + p * 2)) << 16);
                *(GAS unsigned short*)(YS + (size_t)(row0 + 128 * c + q) * LDACT + hd * 64 + p) = (unsigned short)f2bf(yacc[r] + Dk * xv); } }
        const int pi = w >> 2, ni = w & 3;
        { const float dec = scal[0];
#pragma unroll
            for (int i = 0; i < 16; ++i) hacc[i] *= dec;
#pragma unroll
            for (int ks = 0; ks < 8; ++ks) {
                const LAS unsigned char* xp = Xs + (16 * ks + 8 * hi + trq) * XSTR + (32 * pi + 16 * blk + 4 * trp) * 2;
                const bf16x8 xa = tr2(xp, xp + 4 * XSTR);
                const f32x4 w0 = *(const LAS f32x4*)(wdt + 16 * ks + 8 * hi), w1 = *(const LAS f32x4*)(wdt + 16 * ks + 8 * hi + 4);
                v4u aw; { const v4u xw = __builtin_bit_cast(v4u, xa);
                    aw.x = pk2(bflo(xw.x) * w0[0], bfhi(xw.x) * w0[1]); aw.y = pk2(bflo(xw.y) * w0[2], bfhi(xw.y) * w0[3]);
                    aw.z = pk2(bflo(xw.z) * w1[0], bfhi(xw.z) * w1[1]); aw.w = pk2(bflo(xw.w) * w1[2], bfhi(xw.w) * w1[3]); }
                const int rb = 16 * ks + 8 * hi + trq, cb = 4 * ni + 2 * blk + (trp >> 1);
                const bf16x8 bfr = tr2(Bs + swz(rb, cb) + 8 * (trp & 1), Bs + swz(rb + 4, cb) + 8 * (trp & 1));
                hacc = __builtin_amdgcn_mfma_f32_32x32x16_bf16(__builtin_bit_cast(bf16x8, aw), bfr, hacc, 0, 0, 0); } }
        __syncthreads();
#pragma unroll
        for (int g4 = 0; g4 < 4; ++g4) { v2u pw; pw.x = pk2(hacc[4 * g4], hacc[4 * g4 + 1]); pw.y = pk2(hacc[4 * g4 + 2], hacc[4 * g4 + 3]);
            *(LAS v2u*)(Ht + (32 * ni + r32) * XSTR + (32 * pi + 8 * g4 + 4 * hi) * 2) = pw; }
    }
#undef SSD_LOAD
    { const int pi = w >> 2, ni = w & 3; float* hp = a.out + O_SSP + ((size_t)b * NHEAD + hd) * HDIM * DSTATE;
#pragma unroll
      for (int r = 0; r < 16; ++r) { const int p = 32 * pi + (r & 3) + 8 * (r >> 2) + 4 * hi; hp[(size_t)p * DSTATE + 32 * ni + r32] = hacc[r]; } }
}

__device__ __forceinline__ void ssd_sample_group(const Frame& F, const Args& a, int b, int g) {
    unsigned char* ws = a.ws;
    const bf16* XC = (const bf16*)(ws + WS_XC); const float* DT = (const float*)(ws + WS_DT); bf16* YS = (bf16*)(ws + WS_ACT) + ACT_YS;
    LAS float* Cf = (LAS float*)(F.lds + RING_OFF); LAS float* Bf = Cf + 8 * 128; LAS float* xs = Bf + 8 * 128;
    LAS float* Gm = xs + 8 * 8 * 64; LAS float* Mm = Gm + 64; LAS float* ea = Mm + 512; LAS float* wd = ea + 64; LAS float* dcs = wd + 64; LAS float* dtl = dcs + 8;
    const int tid = F.tid, lane = F.lane, p = tid >> 3, ng = tid & 7, row0 = NTOK_P + b * SEQ_S;
    __syncthreads();
    for (int id = tid; id < 256; id += 512) { const int arr = id >> 7, t = (id >> 4) & 7, ch = id & 15; float f[8]; ld8bf(XC + (size_t)(row0 + t) * 6144 + (arr ? 4096 : 5120) + g * 128 + ch * 8, f);
        LAS float* d = (arr ? Bf : Cf) + t * 128 + ch * 8;
#pragma unroll
        for (int i = 0; i < 8; ++i) d[i] = f[i]; }
    { const int hh = tid >> 6, t = (tid >> 3) & 7, ch = tid & 7; float f[8]; ld8bf(XC + (size_t)(row0 + t) * 6144 + (g * 8 + hh) * 64 + ch * 8, f);
#pragma unroll
      for (int i = 0; i < 8; ++i) xs[(hh * 8 + t) * 64 + ch * 8 + i] = f[i]; }
    if (tid < 64) dtl[tid] = DT[(size_t)(row0 + (tid & 7)) * 64 + g * 8 + (tid >> 3)];
    const float* hin = a.in[I_SSM] + (((size_t)b * NHEAD + g * 8) * HDIM + p) * DSTATE + ng * 16;
    float* hout = a.out + O_SSS + (((size_t)b * NHEAD + g * 8) * HDIM + p) * DSTATE + ng * 16;
    f32x4 hn[4];
#pragma unroll
    for (int i = 0; i < 4; ++i) hn[i] = *(const GAS f32x4*)(hin + 4 * i);
    __syncthreads();
    { const int t = tid >> 6, s = (tid >> 3) & 7; float d = 0.f;
#pragma unroll
      for (int i = 0; i < 16; ++i) d += Cf[t * 128 + ng * 16 + i] * Bf[s * 128 + ng * 16 + i];
      d += __shfl_xor(d, 1); d += __shfl_xor(d, 2); d += __shfl_xor(d, 4);
      if (ng == 0) Gm[t * 8 + s] = d; }
    __syncthreads();
    { const int hh = tid >> 6, t = (tid >> 3) & 7, s = tid & 7, hd = g * 8 + hh; const float A = -__expf(a.in[I_ALOG][hd]), Dk = a.in[I_DSK][hd];
      float act = 0.f, acs = 0.f, ac7 = 0.f;
#pragma unroll
      for (int j = 0; j < 8; ++j) { const float aj = dtl[hh * 8 + j] * A; if (j <= t) act += aj; if (j <= s) acs += aj; ac7 += aj; }
      const float dts_ = dtl[hh * 8 + s];
      float m = s <= t ? Gm[t * 8 + s] * __expf(act - acs) * dts_ : 0.f; if (s == t) m += Dk;
      Mm[(hh * 8 + t) * 8 + s] = m;
      if (t == 0) wd[hh * 8 + s] = dts_ * __expf(ac7 - acs);
      if (s == 0) ea[hh * 8 + t] = __expf(act);
      if (s == 0 && t == 0) dcs[hh] = __expf(ac7); }
    __syncthreads();
#pragma unroll 1
    for (int hh = 0; hh < 8; ++hh) {
        asm volatile("" ::: "memory");
        float h[16];
#pragma unroll
        for (int i = 0; i < 4; ++i) { h[4 * i] = hn[i].x; h[4 * i + 1] = hn[i].y; h[4 * i + 2] = hn[i].z; h[4 * i + 3] = hn[i].w; }
        if (hh + 1 < 8) {
#pragma unroll
            for (int i = 0; i < 4; ++i) hn[i] = *(const GAS f32x4*)(hin + (size_t)(hh + 1) * HDIM * DSTATE + 4 * i); }
        float v[8];
#pragma unroll
        for (int t = 0; t < 8; ++t) { float d = 0.f;
#pragma unroll
            for (int i = 0; i < 4; ++i) { const f32x4 cv = *(const LAS f32x4*)(Cf + t * 128 + ng * 16 + 4 * i); d += h[4 * i] * cv.x + h[4 * i + 1] * cv.y + h[4 * i + 2] * cv.z + h[4 * i + 3] * cv.w; }
            v[t] = d; }
        float u[4], z[2], dot;
        { const bool b2 = (lane & 4) != 0;
#pragma unroll
          for (int k = 0; k < 4; ++k) { const float send = b2 ? v[k] : v[k + 4], keep = b2 ? v[k + 4] : v[k]; u[k] = keep + __shfl_xor(send, 4); }
          const bool b1 = (lane & 2) != 0;
#pragma unroll
          for (int k = 0; k < 2; ++k) { const float send = b1 ? u[k] : u[k + 2], keep = b1 ? u[k + 2] : u[k]; z[k] = keep + __shfl_xor(send, 2); }
          const bool b0 = (lane & 1) != 0;
          const float send = b0 ? z[0] : z[1], keep = b0 ? z[1] : z[0]; dot = keep + __shfl_xor(send, 1); }
        { const int t = ng; float y = ea[hh * 8 + t] * dot;
#pragma unroll
          for (int s = 0; s < 8; ++s) y += Mm[(hh * 8 + t) * 8 + s] * xs[(hh * 8 + s) * 64 + p];
          *(GAS unsigned short*)(YS + (size_t)(row0 + t) * LDACT + (g * 8 + hh) * 64 + p) = (unsigned short)f2bf(y); }
        { const float dec = dcs[hh];
#pragma unroll
          for (int i = 0; i < 16; ++i) h[i] *= dec;
#pragma unroll
          for (int s = 0; s < 8; ++s) { const float cf = wd[hh * 8 + s] * xs[(hh * 8 + s) * 64 + p];
#pragma unroll
              for (int i = 0; i < 4; ++i) { const f32x4 bv = *(const LAS f32x4*)(Bf + s * 128 + ng * 16 + 4 * i); h[4 * i] += cf * bv.x; h[4 * i + 1] += cf * bv.y; h[4 * i + 2] += cf * bv.z; h[4 * i + 3] += cf * bv.w; } }
          float* ho = hout + (size_t)hh * HDIM * DSTATE;
#pragma unroll
          for (int i = 0; i < 4; ++i) *(GAS f32x4*)(ho + 4 * i) = (f32x4){h[4 * i], h[4 * i + 1], h[4 * i + 2], h[4 * i + 3]}; }
    }
}

template <int KIND> __device__ __forceinline__ void tail_reduce(const Frame& F, gu32* ctl, int phase, const float* SLAB, void* OUT) {
    if (F.G != 256) return;
    const int i = F.vcu, tt = i >> 3, s = i & 7;
    if (F.tid == 0) {
        unsigned* c = (unsigned*)(ctl + CW_CNT + 64 * (32 * phase + tt));
        __builtin_amdgcn_fence(__ATOMIC_RELEASE, "agent");
        asm volatile("s_waitcnt vmcnt(0)" ::: "memory");
        xb_add(c, 1u);
        unsigned sp = 0;
        while (xb_ld(c) < 8u) { __builtin_amdgcn_s_sleep(1); if (++sp > (1u << 21)) { atomicAdd((unsigned*)(ctl + CW_TMO), 1u); break; } }
        __builtin_amdgcn_fence(__ATOMIC_ACQUIRE, "agent");
        asm volatile("s_waitcnt vmcnt(0)" ::: "memory");
    }
    __syncthreads();
    const float* sb = SLAB + (size_t)(tt * 8) * 65536;
    const int prow = (32 + (tt >> 3)) * 256, pcol = (tt & 7) * 256;
#pragma unroll
    for (int j = 0; j < 4; ++j) { const int idx = F.tid + 512 * j, r = 32 * s + (idx >> 6), c4 = (idx & 63) * 4;
        f32x4 sum = *(const GAS f32x4*)(sb + (size_t)r * 256 + c4);
#pragma unroll
        for (int q = 1; q < 8; ++q) sum += *(const GAS f32x4*)(sb + (size_t)q * 65536 + (size_t)r * 256 + c4);
        const size_t o = (size_t)(prow + r) * DM + pcol + c4;
        if (KIND == 0) { v2u w; w.x = pk2(sum.x, sum.y); w.y = pk2(sum.z, sum.w); *(GAS v2u*)((bf16*)OUT + o) = w; }
        else *(GAS f32x4*)((float*)OUT + o) = sum; }
}

__global__ void __launch_bounds__(NWAVES * 64, 2) fwd(Args args) {
    extern __shared__ __attribute__((aligned(16))) unsigned char lds[];
    Frame F;
    F.lds = (LAS unsigned char*)lds;
    volatile LAS unsigned* MISC = (volatile LAS unsigned*)(F.lds + MISC_OFF);
    F.tid = threadIdx.x; F.lane = F.tid & 63; F.wave = __builtin_amdgcn_readfirstlane(F.tid >> 6);
    F.G = gridDim.x; { const int bx = blockIdx.x; F.vcu = (F.G % 8 == 0) ? (bx % 8) * (F.G / 8) + bx / 8 : bx; }
    unsigned char* ws = args.ws;
    gu32* ctl = (gu32*)(ws + WS_CTL);
    for (int u = F.tid; u < (LDS_BYTES - LDSCTL_OFF) / 4; u += NWAVES * 64) ((LAS unsigned*)(F.lds + LDSCTL_OFF))[u] = 0u;
    __syncthreads();
    XcdBarrier bar; bar.bar = (unsigned*)(ctl + CW_BAR); bar.x = 0; bar.st = nullptr;
    if (!MK_PER_PHASE) bar = xcd_barrier_post((unsigned*)(ctl + CW_BAR), MISC + 8);
    const int lo = args.ph_lo, hi = args.ph_hi;
#define IN(k) (lo <= (k) && (k) < hi)
#define SEAM(k) do { if (IN(k) && IN((k) + 1)) xcd_barrier(bar); } while (0)
    const int G = F.G, cu = (int)blockIdx.x;

    if (IN(0)) { phase_prologue(F, args); } SEAM(0);

    if (IN(1)) {
        { pg8::Gemm g{(const pg8::bf16_t*)(ws + WS_XN), (const pg8::bf16_t*)(ws + WS_WIN), DM}; pg8::StaticOrder S; S.init(NTOK, NPAD, DM, G, cu);
          pg8::EpiProj E{(pg8::bf16_t*)(ws + WS_PROJ), (float*)(ws + WS_DT), args.in[I_DTB]};
          pg8::gemm_phase(F.lds + RING_OFF, g, S, E); }
        { pg8::Gemm g{(const pg8::bf16_t*)(ws + WS_MEMN), (const pg8::bf16_t*)(ws + WS_WKV), DM}; pg8::StaticOrder S; S.init(NMEMROW, 1024, DM, G, cu);
          pg8::EpiKV E{args.out + O_MK, args.out + O_MV, (pg8::bf16_t*)(ws + WS_KVB)};
          pg8::gemm_phase(F.lds + RING_OFF, g, S, E); }
    } SEAM(1);

    if (IN(2)) { phase_conv(F, args); } SEAM(2);

    if (IN(3)) {
        for (int u = F.vcu; u < NB_P * NHEAD; u += G) ssd_chunk_unit(F, args, u >> 6, u & 63);
        for (int u = F.vcu; u < NB_S * NGRP; u += G) ssd_sample_group(F, args, u >> 3, u & 7);
        for (int u = F.vcu; u < NB_P * 4 * 16; u += G) attn_unit<false>(F, args, u >> 6, (u >> 4) & 3, u & 15);
        for (int u = F.vcu; u < NB_S * 4; u += G) attn_unit<true>(F, args, u >> 2, u & 3, 0);
        __syncthreads();
    } SEAM(3);

    if (IN(4)) { phase_gnorm(F, args); } SEAM(4);

    if (IN(5)) {
        pg8::Gemm g{(const pg8::bf16_t*)(ws + WS_ACT), (const pg8::bf16_t*)(ws + WS_WCAT), LDACT}; pg8::MixOrder S{F.vcu, G};
        pg8::EpiMix E{(const pg8::bf16_t*)(ws + WS_PROJ), (pg8::bf16_t*)(ws + WS_XN), (float*)(ws + WS_SLAB)};
        pg8::gemm_phase(F.lds + RING_OFF, g, S, E);
        tail_reduce<0>(F, ctl, 0, (const float*)(ws + WS_SLAB), ws + WS_XN);
    } SEAM(5);

    if (IN(6)) {
        pg8::Gemm g{(const pg8::bf16_t*)(ws + WS_XN), (const pg8::bf16_t*)(ws + WS_WO), DM}; pg8::TailOrder S{F.vcu, G, DM / 64};
        pg8::EpiF32 E{(float*)(ws + WS_MX), DM, (float*)(ws + WS_SLAB)}; pg8::gemm_phase(F.lds + RING_OFF, g, S, E);
        tail_reduce<1>(F, ctl, 1, (const float*)(ws + WS_SLAB), ws + WS_MX);
    } SEAM(6);

    if (IN(7)) { phase_res1(F, args); } SEAM(7);

    if (IN(8)) {
        pg8::Gemm g{(const pg8::bf16_t*)(ws + WS_XN), (const pg8::bf16_t*)(ws + WS_W1), DM}; pg8::StaticOrder S; S.init(NTOK, DFF, DM, G, cu);
        pg8::EpiRelu2 E{(pg8::bf16_t*)(ws + WS_PROJ), DFF}; pg8::gemm_phase(F.lds + RING_OFF, g, S, E);
    } SEAM(8);

    if (IN(9)) {
        pg8::Gemm g{(const pg8::bf16_t*)(ws + WS_PROJ), (const pg8::bf16_t*)(ws + WS_W2), DFF}; pg8::TailOrder S{F.vcu, G, DFF / 64};
        pg8::EpiF32 E{(float*)(ws + WS_ACT), DM, (float*)(ws + WS_SLAB)}; pg8::gemm_phase(F.lds + RING_OFF, g, S, E);
        tail_reduce<1>(F, ctl, 2, (const float*)(ws + WS_SLAB), ws + WS_ACT);
    } SEAM(9);

    if (IN(10)) { phase_res2(F, args); }
#undef IN
#undef SEAM
}

extern "C" void kernel_launch(void* const* d_in, const int* in_sizes, int n_in, void* d_out, int out_size, void* d_ws, size_t ws_size, hipStream_t stream) {
    static int grid = 0;
    if (grid == 0) {
        if (n_in != 28 || ws_size < WS_END) { fprintf(stderr, "kernel_launch: built for 28 inputs and >= %zu bytes of workspace; got n_in %d, ws %zu; nothing launched\n", (size_t)WS_END, n_in, ws_size); grid = -1; return; }
        int dev = 0, cus = 0, per_cu = 0;
        if (hipGetDevice(&dev) != hipSuccess || hipDeviceGetAttribute(&cus, hipDeviceAttributeMultiprocessorCount, dev) != hipSuccess) { grid = -1; return; }
        if (hipFuncSetAttribute((const void*)fwd, hipFuncAttributeMaxDynamicSharedMemorySize, LDS_BYTES) != hipSuccess) { fprintf(stderr, "kernel_launch: hipFuncSetAttribute failed\n"); grid = -1; return; }
        if (hipOccupancyMaxActiveBlocksPerMultiprocessor(&per_cu, (const void*)fwd, NWAVES * 64, LDS_BYTES) != hipSuccess || per_cu < 1)
            fprintf(stderr, "kernel_launch: note: occupancy query reports %d workgroups per CU\n", per_cu);
        (void)hipGetLastError();
        grid = cus;
    }
    if (grid < 0) return;
    if (hipMemsetAsync((char*)d_ws + WS_CTL, 0, CTL_ZERO_BYTES, stream) != hipSuccess) { fprintf(stderr, "kernel_launch: hipMemsetAsync failed\n"); return; }
    Args a{};
    for (int i = 0; i < 28; ++i) a.in[i] = (const float*)d_in[i];
    a.out = (float*)d_out; a.ws = (unsigned char*)d_ws;
#if MK_PER_PHASE
    for (int p = 0; p < N_PHASES; ++p) { a.ph_lo = p; a.ph_hi = p + 1; for (int rep = 0; rep < (((REP_MASK >> p) & 1) ? 2 : 1); ++rep) hipLaunchKernelGGL(fwd, dim3(grid), dim3(NWAVES * 64), LDS_BYTES, stream, a); }
#else
    a.ph_lo = 0; a.ph_hi = N_PHASES;
    hipLaunchKernelGGL(fwd, dim3(grid), dim3(NWAVES * 64), LDS_BYTES, stream, a);
#endif
    const hipError_t le = hipPeekAtLastError();
    if (le != hipSuccess) fprintf(stderr, "kernel_launch: launch failed: %s\n", hipGetErrorName(le));
}
```
